# Optimizing an MI355X kernel written in HIP

```python
import math
import jax, jax.numpy as jnp
from jax import lax
import numpy as np

D_MODEL = 1024
BATCH = 4
SEQ = 4096
DEPTH = 4

CHUNK = 64
Q_BLOCK = 128
MIX_WIDTH = D_MODEL
DIFF_WIDTH = MIX_WIDTH // 2
HGRN_WIDTH = MIX_WIDTH - DIFF_WIDTH
DIFF_HEAD_DIM = 64
DIFF_HEADS = DIFF_WIDTH // (2 * DIFF_HEAD_DIM)
HGRN_EXPAND = 128
HGRN_HEADS = HGRN_WIDTH // HGRN_EXPAND
HGRN_DK = HGRN_EXPAND
HGRN_DV = HGRN_WIDTH // HGRN_HEADS
D_FF = ((8 * D_MODEL + 3 * 256 - 1) // (3 * 256)) * 256
NORM_EPS = 1e-6

IN_WIDTHS = (
    2 * DIFF_HEADS * DIFF_HEAD_DIM,
    2 * DIFF_HEADS * DIFF_HEAD_DIM,
    DIFF_HEADS * 2 * DIFF_HEAD_DIM,
    HGRN_HEADS * HGRN_DK,
    HGRN_HEADS * HGRN_DK,
    HGRN_HEADS * HGRN_DV,
    HGRN_HEADS * HGRN_DV,
)
D_IN = sum(IN_WIDTHS)
SPLIT_POINTS = tuple(int(v) for v in np.cumsum(IN_WIDTHS)[:-1])

kernel_name = "hymba_diffattn_hgrn2_trunk"


def rms_norm(x, g):
    xf = x.astype(jnp.float32)
    y = xf * lax.rsqrt(jnp.mean(xf * xf, axis=-1, keepdims=True) + NORM_EPS)
    return (y * g.astype(jnp.float32)).astype(x.dtype)


def diff_attention(q, k, v, lam):
    B, H2, S, Dh = q.shape
    H = H2 // 2
    nb = S // Q_BLOCK
    qb = q.reshape(B, H2, nb, Q_BLOCK, Dh).transpose(2, 0, 1, 3, 4)
    key_chunk = jnp.arange(S) // CHUNK

    def one_block(args):
        q_blk, blk = args
        q_chunk = (blk * Q_BLOCK + jnp.arange(Q_BLOCK)) // CHUNK
        mask = key_chunk[None, :] <= q_chunk[:, None]
        s = jnp.einsum('bhqd,bhkd->bhqk', q_blk, k).astype(jnp.float32)
        p = jax.nn.softmax(jnp.where(mask, s, -jnp.inf), axis=-1)
        p = p.reshape(B, H, 2, Q_BLOCK, S)
        w = p[:, :, 0] - lam * p[:, :, 1]
        return jnp.einsum('bhqk,bhkv->bhqv', w.astype(v.dtype), v)

    out = lax.map(one_block, (qb, jnp.arange(nb)))
    return out.transpose(1, 2, 0, 3, 4).reshape(B, H, S, v.shape[-1])


def hgrn2_chunked(q, k, v, lf):
    B, S, H, dk = q.shape
    dv = v.shape[-1]
    nc = S // CHUNK

    def to_chunks(t):
        return t.reshape(B, nc, CHUNK, H, t.shape[-1]).transpose(1, 0, 3, 2, 4)

    qc, kc, vc, lfc = to_chunks(q), to_chunks(k), to_chunks(v), to_chunks(lf)
    bc = jnp.cumsum(lfc, axis=3)
    causal = jnp.tril(jnp.ones((CHUNK, CHUNK), dtype=bool))

    def step(state, inp):
        q_c, k_c, v_c, b_c = inp
        diff = b_c[:, :, :, None, :] - b_c[:, :, None, :, :]
        decay = jnp.exp(jnp.where(causal[:, :, None], diff, -jnp.inf))
        scores = jnp.einsum('bhtk,bhsk,bhtsk->bhts', q_c, k_c, decay)
        o = (jnp.einsum('bhts,bhsv->bhtv', scores, v_c)
             + jnp.einsum('bhtk,bhkv->bhtv', q_c * jnp.exp(b_c), state))
        b_last = b_c[:, :, -1:, :]
        state = (jnp.exp(b_last[:, :, 0, :, None]) * state
                 + jnp.einsum('bhsk,bhsv->bhkv', k_c * jnp.exp(b_last - b_c), v_c))
        return state, o

    state0 = jnp.zeros((B, H, dk, dv), jnp.float32)
    _, o = lax.scan(step, state0, (qc, kc, vc, bc))
    return o.transpose(1, 0, 3, 2, 4).reshape(B, S, H, dv)


def setup_inputs(seed: int = 0) -> dict:
    key = jax.random.key(seed)
    ks = jax.random.split(key, 17)

    def normal(k, shape, scale):
        return jax.random.normal(k, shape, jnp.float32) * scale

    return {
        "x": normal(ks[0], (BATCH, SEQ, D_MODEL), 1.0),
        "attn_norm_g": 1.0 + normal(ks[1], (DEPTH, D_MODEL), 0.02),
        "w_in": normal(ks[2], (DEPTH, D_MODEL, D_IN), D_MODEL ** -0.5),
        "q_norm_g": 1.0 + normal(ks[3], (DEPTH, DIFF_HEAD_DIM), 0.02),
        "k_norm_g": 1.0 + normal(ks[4], (DEPTH, DIFF_HEAD_DIM), 0.02),
        "lambda_q1": normal(ks[5], (DEPTH, DIFF_HEAD_DIM), 0.1),
        "lambda_k1": normal(ks[6], (DEPTH, DIFF_HEAD_DIM), 0.1),
        "lambda_q2": normal(ks[7], (DEPTH, DIFF_HEAD_DIM), 0.1),
        "lambda_k2": normal(ks[8], (DEPTH, DIFF_HEAD_DIM), 0.1),
        "subln_g": 1.0 + normal(ks[9], (DEPTH, 2 * DIFF_HEAD_DIM), 0.02),
        "lower_bounds": normal(ks[10], (DEPTH, HGRN_HEADS * HGRN_DK), 0.1),
        "hgrn_norm_g": 1.0 + normal(ks[11], (DEPTH, HGRN_DV), 0.02),
        "w_out": normal(ks[12], (DEPTH, MIX_WIDTH, D_MODEL), MIX_WIDTH ** -0.5),
        "ffn_norm_g": 1.0 + normal(ks[13], (DEPTH, D_MODEL), 0.02),
        "w_gate": normal(ks[14], (DEPTH, D_MODEL, D_FF), D_MODEL ** -0.5),
        "w_up": normal(ks[15], (DEPTH, D_MODEL, D_FF), D_MODEL ** -0.5),
        "w_down": normal(ks[16], (DEPTH, D_FF, D_MODEL), D_FF ** -0.5),
    }


def reference(x, attn_norm_g, w_in, q_norm_g, k_norm_g, lambda_q1, lambda_k1,
              lambda_q2, lambda_k2, subln_g, lower_bounds, hgrn_norm_g, w_out,
              ffn_norm_g, w_gate, w_up, w_down):
    B, S, _ = x.shape
    gamma = jax.nn.softmax(lower_bounds.astype(jnp.float32), axis=0)
    lbs = jnp.cumsum(gamma, axis=0) - gamma[0]

    for l in range(DEPTH):
        h = rms_norm(x, attn_norm_g[l])
        proj = jnp.einsum('bsd,de->bse', h, w_in[l])
        qd, kd, vd, qr, fr, ir, gr = jnp.split(proj, SPLIT_POINTS, axis=-1)

        qd = rms_norm(qd.reshape(B, S, 2 * DIFF_HEADS, DIFF_HEAD_DIM), q_norm_g[l]) * (DIFF_HEAD_DIM ** -0.5)
        kd = rms_norm(kd.reshape(B, S, 2 * DIFF_HEADS, DIFF_HEAD_DIM), k_norm_g[l])
        vd = vd.reshape(B, S, DIFF_HEADS, 2 * DIFF_HEAD_DIM)
        lam_init = 0.8 - 0.6 * math.exp(-0.3 * l)
        lam = (jnp.exp(jnp.sum(lambda_q1[l].astype(jnp.float32) * lambda_k1[l].astype(jnp.float32)))
               - jnp.exp(jnp.sum(lambda_q2[l].astype(jnp.float32) * lambda_k2[l].astype(jnp.float32)))
               + lam_init)
        od = diff_attention(qd.transpose(0, 2, 1, 3), kd.transpose(0, 2, 1, 3),
                            vd.transpose(0, 2, 1, 3), lam)
        od = rms_norm(od, subln_g[l]) * (1.0 - lam_init)
        od = od.transpose(0, 2, 1, 3).reshape(B, S, DIFF_WIDTH)

        fz = fr.astype(jnp.float32).reshape(B, S, HGRN_HEADS, HGRN_DK)
        if l == 0:
            lf = jax.nn.log_sigmoid(fz)
        else:
            lb = lbs[l].reshape(HGRN_HEADS, HGRN_DK)
            lf = jnp.log(lb + (1.0 - lb) * jax.nn.sigmoid(fz))
        kr = -jnp.expm1(lf)
        qr = jax.nn.silu(qr.astype(jnp.float32)).reshape(B, S, HGRN_HEADS, HGRN_DK)
        vr = ir.astype(jnp.float32).reshape(B, S, HGRN_HEADS, HGRN_DV)
        orr = hgrn2_chunked(qr, kr, vr, lf).astype(x.dtype)
        orr = rms_norm(orr, hgrn_norm_g[l]) * jax.nn.silu(gr.reshape(B, S, HGRN_HEADS, HGRN_DV))
        orr = orr.reshape(B, S, HGRN_WIDTH)

        mix = jnp.concatenate([od.astype(x.dtype), orr.astype(x.dtype)], axis=-1)
        x = x + jnp.einsum('bse,ed->bsd', mix, w_out[l])

        h = rms_norm(x, ffn_norm_g[l])
        ff = jax.nn.silu(jnp.einsum('bsd,df->bsf', h, w_gate[l])) * jnp.einsum('bsd,df->bsf', h, w_up[l])
        x = x + jnp.einsum('bsf,fd->bsd', ff, w_down[l])
    return x
```

```cpp
#include <hip/hip_runtime.h>
#include <hip/hip_cooperative_groups.h>
#include <hip/hip_bf16.h>
#include <cstdio>
#include <cstdint>
#include <cmath>
namespace cg = cooperative_groups;
#ifndef MK_PER_PHASE_LAUNCHES
#define MK_PER_PHASE_LAUNCHES 0
#endif
namespace pg8 {
#define PG8_LAS __attribute__((address_space(3)))
typedef unsigned short bf16_t;
typedef short bf16x8 __attribute__((ext_vector_type(8)));
typedef float f32x4 __attribute__((ext_vector_type(4)));
typedef unsigned u32x4 __attribute__((ext_vector_type(4)));
constexpr int BM = 256, BK = 64, HALF = 128, HTB = HALF * BK * 2  , STAGE_BYTES = 8 * HTB, NXCD = 8, WGM = 8;

__host__ __device__ __forceinline__ int lds_byte(int r, int c) { const int st = (r >> 4) * 2 + (c >> 5), rr = r & 15, cc = c & 31, ob = rr * 64 + cc * 2; return st * 1024 + (ob ^ (((ob >> 9) & 1) << 5)); }
__host__ __device__ __forceinline__ void stage_rc(int b, int& R, int& C) { const int st = b / 1024, sb = b % 1024, swz = sb ^ (((sb >> 9) & 1) << 5); R = (st >> 1) * 16 + swz / 64; C = (st & 1) * 32 + (swz % 64) / 2; }
__host__ __device__ __forceinline__ int perm32(int rho) { const int n = rho >> 4, i = rho & 15; return 8 * (i >> 2) + 4 * n + (i & 3); }

struct Unit { int pm, pn; };
struct Gemm { const bf16_t* A; const bf16_t* Bt; int M, N, K; };

struct StaticOrder {
    int nM, nN, nwg, G, c;
    __host__ __device__ void init(int M, int N, int G_, int c_) { nM = M / BM; nN = N / BM; nwg = nM * nN; G = G_; c = c_; }
    __host__ __device__ bool next(int i, Unit& u) const {
        const long L = (long)i * G + c; if (L >= nwg) return false;
        int wgid = (int)L; { const int q = nwg / NXCD, r = nwg % NXCD, xcd = wgid % NXCD, off = wgid / NXCD; wgid = (xcd < r ? xcd * (q + 1) : r * (q + 1) + (xcd - r) * q) + off; }
        const int nig = WGM * nN, gid = wgid / nig, fm = gid * WGM, gsz = (nM - fm) < WGM ? (nM - fm) : WGM;
        u.pm = fm + ((wgid % nig) % gsz); u.pn = (wgid % nig) / gsz; return true;
    }
    __device__ __forceinline__ void a_ready(const Unit&) const {}
    __device__ __forceinline__ void done(const Unit&) const {}
};

__device__ __forceinline__ unsigned cvt_pk_bf16(float lo, float hi) { unsigned r; asm volatile("v_cvt_pk_bf16_f32 %0, %1, %2" : "=v"(r) : "v"(lo), "v"(hi)); return r; }

template <class Epi, class Sched, bool ALIGN_EPI = false, bool SP2 = false>
__device__ __forceinline__ void gemm_phase(PG8_LAS unsigned char* lds, const Gemm g, const Sched& S, const Epi& E) {
    int tid_ = threadIdx.x; asm volatile("" : "+v"(tid_));
    const int tid = tid_, wid = __builtin_amdgcn_readfirstlane(tid >> 6), lane = tid & 63, wr = wid >> 2, wc = wid & 3, fr = lane & 15, fq = lane >> 4;
    const int K = g.K, nt = K / BK;
    unsigned voffA[2], voffB[2];
#pragma unroll
    for (int i = 0; i < 2; ++i) { int R, C; stage_rc(tid * 16 + i * 8192, R, C); const int Rb = Epi::PERM ? ((R & ~31) + perm32(R & 31)) : R;
        voffA[i] = (unsigned)(R * K + C) * 2u; voffB[i] = (unsigned)(Rb * K + C) * 2u; }
    const size_t kstep = (size_t)(BK * 2);
    const size_t hstep = (size_t)HALF * K * 2;
    const size_t tstep = 2 * hstep;
    const unsigned ldsw = (unsigned)wid * 1024u;
    const int aoff = lds_byte(wr * 64 + fr, fq * 8), boff = lds_byte(wc * 32 + fr, fq * 8);
#define PG8_SA(b, h) (((b) * 2 + (h)) * HTB)
#define PG8_SB(b, h) ((4 + (b) * 2 + (h)) * HTB)
#define PG8_STAGE(bufoff, gbase, voff) do { _Pragma("unroll") for (int _i = 0; _i < 2; ++_i) \
        __builtin_amdgcn_global_load_lds((const unsigned*)((const char*)(gbase) + (voff)[_i]), (PG8_LAS unsigned*)(lds + (bufoff) + ldsw + _i * 8192), 16, 0, 0); } while (0)
#define PG8_LDA(dst, b, h) do { _Pragma("unroll") for (int m = 0; m < 4; ++m) _Pragma("unroll") for (int k = 0; k < 2; ++k) dst[m][k] = *(const PG8_LAS bf16x8*)(lds + PG8_SA(b, h) + aoff + m * 2048 + k * 1024); } while (0)
#define PG8_LDB(dst, b, h) do { _Pragma("unroll") for (int n = 0; n < 2; ++n) _Pragma("unroll") for (int k = 0; k < 2; ++k) dst[n][k] = *(const PG8_LAS bf16x8*)(lds + PG8_SB(b, h) + boff + n * 2048 + k * 1024); } while (0)
#define PG8_MMA(ai, bj, At, Bt) do { __builtin_amdgcn_s_setprio(1); _Pragma("unroll") for (int m = 0; m < 4; ++m) _Pragma("unroll") for (int n = 0; n < 2; ++n) _Pragma("unroll") for (int k = 0; k < 2; ++k) \
        acc[ai][bj][m][n] = __builtin_amdgcn_mfma_f32_16x16x32_bf16(Bt[n][k], At[m][k], acc[ai][bj][m][n], 0, 0, 0); __builtin_amdgcn_s_setprio(0); } while (0)
#define PG8_WAIT_V(n) asm volatile("s_waitcnt vmcnt(" #n ")" ::: "memory")
#define PG8_WAIT_L(n) asm volatile("s_waitcnt lgkmcnt(" #n ")" ::: "memory")
#define PG8_BAR __builtin_amdgcn_s_barrier()
#define PG8_SCHED __builtin_amdgcn_sched_barrier(0)
    Unit cur, nxt; int ui = 0;
    if (!S.next(0, cur)) return;
    f32x4 acc[2][2][4][2];
#pragma unroll
    for (int a = 0; a < 2; ++a)
#pragma unroll
        for (int b = 0; b < 2; ++b)
#pragma unroll
            for (int m = 0; m < 4; ++m)
#pragma unroll
                for (int n = 0; n < 2; ++n) acc[a][b][m][n] = (f32x4){0.f, 0.f, 0.f, 0.f};
    bf16x8 At[4][2], B0[2][2], B1[2][2];
    const char* cA = (const char*)g.A + (size_t)cur.pm * tstep; const char* cB = (const char*)g.Bt + (size_t)cur.pn * tstep;
    S.a_ready(cur);
    if constexpr (SP2) {
        PG8_STAGE(PG8_SB(0, 0), cB, voffB); PG8_STAGE(PG8_SB(0, 1), cB + hstep, voffB); PG8_STAGE(PG8_SA(0, 0), cA, voffA); PG8_STAGE(PG8_SA(0, 1), cA + hstep, voffA);
        if (wr == 1) PG8_BAR;
        PG8_WAIT_V(2); PG8_BAR;
        PG8_STAGE(PG8_SB(1, 0), cB + kstep, voffB); PG8_STAGE(PG8_SA(1, 0), cA + kstep, voffA); PG8_STAGE(PG8_SB(1, 1), cB + hstep + kstep, voffB);
        PG8_WAIT_V(6); PG8_BAR;
    } else {
        PG8_STAGE(PG8_SB(0, 0), cB, voffB); PG8_STAGE(PG8_SA(0, 0), cA, voffA); PG8_STAGE(PG8_SB(0, 1), cB + hstep, voffB); PG8_STAGE(PG8_SA(0, 1), cA + hstep, voffA);
        if (wr == 1) PG8_BAR;
        PG8_WAIT_V(4); PG8_BAR;
        PG8_STAGE(PG8_SB(1, 0), cB + kstep, voffB); PG8_STAGE(PG8_SA(1, 0), cA + kstep, voffA); PG8_STAGE(PG8_SB(1, 1), cB + hstep + kstep, voffB);
        PG8_WAIT_V(6); PG8_BAR;
    }
    for (;;) {
        const bool has_next = S.next(ui + 1, nxt);
        const char* nA = has_next ? (const char*)g.A + (size_t)nxt.pm * tstep : cA; const char* nB = has_next ? (const char*)g.Bt + (size_t)nxt.pn * tstep : cB;
        for (int t = 0; t < nt; t += 2) {
            const bool last = (t == nt - 2);
            const char* a1 = cA + (size_t)(t + 1) * kstep;
            const char* a2 = last ? nA : cA + (size_t)(t + 2) * kstep; const char* b2 = last ? nB : cB + (size_t)(t + 2) * kstep;
            const char* a3 = a2 + kstep; const char* b3 = b2 + kstep;
            if (last && has_next) S.a_ready(nxt);
            if constexpr (SP2) {
            PG8_LDB(B0, 0, 0); PG8_LDB(B1, 0, 1); PG8_SCHED; PG8_LDA(At, 0, 0); PG8_STAGE(PG8_SA(1, 1), a1 + hstep, voffA);
            PG8_WAIT_V(8); PG8_WAIT_L(0); PG8_BAR; PG8_MMA(0, 0, At, B0); PG8_MMA(0, 1, At, B1); PG8_BAR; PG8_SCHED;
            PG8_LDA(At, 0, 1); PG8_STAGE(PG8_SB(0, 0), b2, voffB); PG8_STAGE(PG8_SB(0, 1), b2 + hstep, voffB); PG8_STAGE(PG8_SA(0, 0), a2, voffA);
            PG8_WAIT_V(8); PG8_WAIT_L(0); PG8_BAR; PG8_MMA(1, 0, At, B0); PG8_MMA(1, 1, At, B1); PG8_BAR; PG8_SCHED;
            PG8_LDB(B0, 1, 0); PG8_LDB(B1, 1, 1); PG8_SCHED; PG8_LDA(At, 1, 0); PG8_STAGE(PG8_SA(0, 1), a2 + hstep, voffA);
            PG8_WAIT_V(8); PG8_WAIT_L(0); PG8_BAR; PG8_MMA(0, 0, At, B0); PG8_MMA(0, 1, At, B1); PG8_BAR; PG8_SCHED;
            PG8_LDA(At, 1, 1); PG8_STAGE(PG8_SB(1, 0), b3, voffB); PG8_STAGE(PG8_SB(1, 1), b3 + hstep, voffB); PG8_STAGE(PG8_SA(1, 0), a3, voffA);
            PG8_WAIT_V(8); PG8_WAIT_L(0); PG8_BAR; PG8_MMA(1, 0, At, B0); PG8_MMA(1, 1, At, B1); PG8_BAR; PG8_SCHED;
            } else {
            PG8_LDB(B0, 0, 0); PG8_SCHED; PG8_LDA(At, 0, 0); PG8_STAGE(PG8_SA(1, 1), a1 + hstep, voffA);
            PG8_WAIT_L(8); PG8_BAR; PG8_WAIT_L(0); PG8_MMA(0, 0, At, B0); PG8_BAR; PG8_SCHED;
            PG8_LDB(B1, 0, 1); PG8_STAGE(PG8_SB(0, 0), b2, voffB);
            PG8_BAR; PG8_WAIT_L(0); PG8_MMA(0, 1, At, B1); PG8_BAR;
            PG8_LDA(At, 0, 1); PG8_STAGE(PG8_SA(0, 0), a2, voffA);
            PG8_BAR; PG8_WAIT_L(0); PG8_MMA(1, 0, At, B0); PG8_BAR; PG8_SCHED;
            PG8_STAGE(PG8_SB(0, 1), b2 + hstep, voffB);
            PG8_WAIT_V(6); PG8_BAR; PG8_MMA(1, 1, At, B1); PG8_BAR;
            PG8_LDB(B0, 1, 0); PG8_SCHED; PG8_LDA(At, 1, 0); PG8_STAGE(PG8_SA(0, 1), a2 + hstep, voffA);
            PG8_WAIT_L(8); PG8_BAR; PG8_WAIT_L(0); PG8_MMA(0, 0, At, B0); PG8_BAR; PG8_SCHED;
            PG8_LDB(B1, 1, 1); PG8_STAGE(PG8_SB(1, 0), b3, voffB);
            PG8_BAR; PG8_WAIT_L(0); PG8_MMA(0, 1, At, B1); PG8_BAR;
            PG8_LDA(At, 1, 1); PG8_STAGE(PG8_SA(1, 0), a3, voffA);
            PG8_BAR; PG8_WAIT_L(0); PG8_MMA(1, 0, At, B0); PG8_BAR; PG8_SCHED;
            PG8_STAGE(PG8_SB(1, 1), b3 + hstep, voffB);
            PG8_WAIT_V(6); PG8_BAR; PG8_MMA(1, 1, At, B1); PG8_BAR;
            }
        }
        if constexpr (ALIGN_EPI) { if (wr == 0) PG8_BAR; }
        if constexpr (!Epi::AFTER_DRAIN) { E(acc, cur, wr, wc, fr, fq); S.done(cur); }
        if (!has_next) break;
#pragma unroll
        for (int a = 0; a < 2; ++a)
#pragma unroll
            for (int b = 0; b < 2; ++b)
#pragma unroll
                for (int m = 0; m < 4; ++m)
#pragma unroll
                    for (int n = 0; n < 2; ++n) acc[a][b][m][n] = (f32x4){0.f, 0.f, 0.f, 0.f};
        cur = nxt; cA = nA; cB = nB; ++ui;
        if constexpr (ALIGN_EPI) { if (wr == 1) PG8_BAR; }
    }
    PG8_WAIT_V(0);
    if constexpr (!ALIGN_EPI) { if (wr == 0) PG8_BAR; }
    PG8_BAR;
    if constexpr (Epi::AFTER_DRAIN) { E.fused(acc, cur, wr, wc, fr, fq, lds, wid, lane); S.done(cur); }
#undef PG8_SA
#undef PG8_SB
#undef PG8_STAGE
#undef PG8_LDA
#undef PG8_LDB
#undef PG8_MMA
#undef PG8_WAIT_V
#undef PG8_WAIT_L
#undef PG8_BAR
#undef PG8_SCHED
}
}
#ifndef PG8_SP2
#define PG8_SP2 true
#endif
namespace attn_body {
using bf16=__hip_bfloat16;
using bf16x8=__attribute__((ext_vector_type(8)))short;
using s16x4=__attribute__((ext_vector_type(4)))short;
using f32x16=__attribute__((ext_vector_type(16)))float;
using u32x4=__attribute__((ext_vector_type(4)))unsigned;
constexpr int BATCH=4,SEQ=4096,D=64,PQ=3584,PO=1024;
constexpr int NW=8,QBLK=32,QB=QBLK*NW,KVBLK=64,NQB=SEQ/QB;
constexpr int ATTN_UNIT_ROWS=QB;
__device__ __forceinline__ int crow(int r,int hi){return (r&3)+8*(r>>2)+4*hi;}
#define SBAR() __builtin_amdgcn_sched_barrier(0)
__device__ __forceinline__ void cmask(f32x16&p0,f32x16&p1,int jb,int wid){
  const float NEG=-INFINITY;
  if(jb>(wid>>1)){
    #pragma unroll
    for(int r=0;r<16;++r){p0[r]=NEG;p1[r]=NEG;}}
}

constexpr int NSLOT=3, SLOTB=8192;
constexpr int LDS_K=0, LDS_V=NSLOT*SLOTB, LDS_WS=3*NSLOT*SLOTB, LDS_OST=LDS_WS+NW*64*4, LDS_BYTES=LDS_OST+NW*4096;
constexpr float C2=0.125f*1.4426950408889634f;
__device__ __forceinline__ void glds16(const void*gsrc,unsigned lds_dst){unsigned keep;
  asm volatile("s_mov_b32 %0, m0\n\ts_mov_b32 m0, %2\n\ts_nop 0\n\tglobal_load_lds_dwordx4 %1, off\n\ts_mov_b32 m0, %0":"=&s"(keep):"v"(gsrc),"s"(lds_dst):"memory");}
__device__ __forceinline__ float max3f(float a,float b,float c){float r;asm("v_max3_f32 %0, %1, %2, %3":"=v"(r):"v"(a),"v"(b),"v"(c));return r;}
__device__ __forceinline__ float max2f(float a,float b){float r;asm("v_max_f32_e32 %0, %1, %2":"=v"(r):"v"(a),"v"(b));return r;}
__device__ __forceinline__ float fadd_s(float a,float b){float r;asm("v_add_f32_e32 %0, %1, %2":"=v"(r):"v"(a),"v"(b));return r;}
__device__ __forceinline__ float fsub_s(float a,float b){float r;asm("v_sub_f32_e32 %0, %1, %2":"=v"(r):"v"(a),"v"(b));return r;}
typedef float f32x2_t __attribute__((ext_vector_type(2))); typedef __bf16 bf16x2_t __attribute__((ext_vector_type(2)));
__device__ __forceinline__ unsigned cvtpk_s(float lo,float hi){f32x2_t v={lo,hi};bf16x2_t b=__builtin_convertvector(v,bf16x2_t);return __builtin_bit_cast(unsigned,b);}
#define WAIT_BAR(N) asm volatile("s_waitcnt vmcnt(" #N ") lgkmcnt(0)\n\ts_barrier":::"memory")

__device__ __forceinline__ void qkt(f32x16&p0,f32x16&p1,const char*Kslot,const bf16x8*qr,const f32x16&negm,int r32,int hi){
  const char*kb=Kslot+hi*1024+r32*16;
  #pragma unroll
  for(int d0=0;d0<4;++d0){
    const bf16x8 b0=*reinterpret_cast<const bf16x8*>(kb+d0*2048);
    const bf16x8 b1=*reinterpret_cast<const bf16x8*>(kb+d0*2048+512);
    if(d0==0){p0=__builtin_amdgcn_mfma_f32_32x32x16_bf16(b0,qr[0],negm,0,0,0);p1=__builtin_amdgcn_mfma_f32_32x32x16_bf16(b1,qr[0],negm,0,0,0);}
    else{p0=__builtin_amdgcn_mfma_f32_32x32x16_bf16(b0,qr[d0],p0,0,0,0);p1=__builtin_amdgcn_mfma_f32_32x32x16_bf16(b1,qr[d0],p1,0,0,0);}}
}
typedef __attribute__((address_space(3))) const char* lds_cptr;
typedef short v4i16_t __attribute__((ext_vector_type(4)));
__device__ __forceinline__ void kload8(bf16x8*kf,lds_cptr kp){
  kf[0]=*(const __attribute__((address_space(3))) bf16x8*)(kp);      kf[1]=*(const __attribute__((address_space(3))) bf16x8*)(kp+512);
  kf[2]=*(const __attribute__((address_space(3))) bf16x8*)(kp+2048); kf[3]=*(const __attribute__((address_space(3))) bf16x8*)(kp+2560);
  kf[4]=*(const __attribute__((address_space(3))) bf16x8*)(kp+4096); kf[5]=*(const __attribute__((address_space(3))) bf16x8*)(kp+4608);
  kf[6]=*(const __attribute__((address_space(3))) bf16x8*)(kp+6144); kf[7]=*(const __attribute__((address_space(3))) bf16x8*)(kp+6656);
}
__device__ __forceinline__ void kload2(bf16x8*kf,lds_cptr kp,int j){ kf[2*j]=*(const __attribute__((address_space(3))) bf16x8*)(kp+j*2048); kf[2*j+1]=*(const __attribute__((address_space(3))) bf16x8*)(kp+j*2048+512); }
__device__ __forceinline__ s16x4 vtr(lds_cptr p){ return __builtin_bit_cast(s16x4,__builtin_amdgcn_ds_read_tr16_b64_v4i16((__attribute__((address_space(3))) v4i16_t*)p)); }
__device__ __forceinline__ float rowmax(const f32x16&p0,const f32x16&p1){
  float a=max3f(p0[0],p0[1],p1[0]),b=max3f(p0[2],p0[3],p1[1]);a=max3f(a,p1[2],p1[3]);
  #pragma unroll
  for(int r=4;r<16;r+=4){a=max3f(a,p0[r],p0[r+1]);b=max3f(b,p0[r+2],p0[r+3]);a=max3f(a,p1[r],p1[r+1]);b=max3f(b,p1[r+2],p1[r+3]);}
  const float m=max2f(a,b);
  auto rr=__builtin_amdgcn_permlane32_swap(__float_as_uint(m),__float_as_uint(m),false,false);
  return max2f(__uint_as_float(rr[0]),__uint_as_float(rr[1]));
}
__device__ __forceinline__ void pv(f32x16*o,int vb,bf16x8 pa0,bf16x8 pa1,bf16x8 pa2,bf16x8 pa3){
  #pragma unroll
  for(int d0=0;d0<2;++d0){s16x4 lo[4],hi[4];
    #pragma unroll
    for(int ks=0;ks<4;++ks){
      asm volatile("ds_read_b64_tr_b16 %0,%1 offset:%c2":"=&v"(lo[ks]):"v"(vb),"i"(d0*4096+ks*1024):"memory");
      asm volatile("ds_read_b64_tr_b16 %0,%1 offset:%c2":"=&v"(hi[ks]):"v"(vb),"i"(d0*4096+ks*1024+512):"memory");}
    asm volatile("s_waitcnt lgkmcnt(0)":::"memory");SBAR();
    #define PK(k) (bf16x8){lo[k][0],lo[k][1],lo[k][2],lo[k][3],hi[k][0],hi[k][1],hi[k][2],hi[k][3]}
    o[d0]=__builtin_amdgcn_mfma_f32_32x32x16_bf16(pa0,PK(0),o[d0],0,0,0);
    o[d0]=__builtin_amdgcn_mfma_f32_32x32x16_bf16(pa1,PK(1),o[d0],0,0,0);
    o[d0]=__builtin_amdgcn_mfma_f32_32x32x16_bf16(pa2,PK(2),o[d0],0,0,0);
    o[d0]=__builtin_amdgcn_mfma_f32_32x32x16_bf16(pa3,PK(3),o[d0],0,0,0);
    #undef PK
  }
}

#ifndef ATTN_STORE16
#define ATTN_STORE16(p,v) (*(u32x4*)(p)=(v))
#endif
template<int THRL> __device__ __forceinline__ void attn_unit(int b,int qcol,int kcol,int vcol,int ocol,int qb,const bf16*__restrict__ P,bf16*O,char*shm){
  int tid_=threadIdx.x; asm volatile("":"+v"(tid_)); const int tid=tid_,lane=tid&63,r32=lane&31,hi=lane>>5; const int wid=__builtin_amdgcn_readfirstlane(tid>>6);
  const long rowbase=(long)b*SEQ; const int q0=qb*QB;
  const bf16*Qw=P+(rowbase+q0+wid*QBLK)*PQ+qcol;
  const bf16*Kh=P+rowbase*PQ+kcol,*Vh=P+rowbase*PQ+vcol;
  const unsigned lds0=(unsigned)(uintptr_t)shm;
  float*wsf=(float*)(shm+LDS_WS)+wid*64;
  const bf16*ksrc=Kh+(long)lane*PQ+wid*8;
  const bf16*vsrc=Vh+(long)(16*(wid&3)+(lane>>2))*PQ+(wid>>2)*32+(lane&3)*8;
  const unsigned kdst=lds0+LDS_K+wid*1024, vdst=lds0+LDS_V+wid*1024;
  #define DMA_K(t,slot) glds16(ksrc+(long)(t)*KVBLK*PQ,(unsigned)__builtin_amdgcn_readfirstlane(kdst+(slot)))
  #define DMA_V(t,slot) do{ glds16(vsrc+(long)(t)*KVBLK*PQ,(unsigned)__builtin_amdgcn_readfirstlane(vdst+2*(slot))); glds16(vsrc+(long)(t)*KVBLK*PQ+64,(unsigned)__builtin_amdgcn_readfirstlane(vdst+2*(slot)+8192)); }while(0)
  const int vb0=(int)(lds0+LDS_V)+((lane>>4)&1)*32+(lane&3)*8+(4*hi+((lane&15)>>2))*64;
  const char*Kbase=shm+LDS_K; bf16x8 kf[8];
  const lds_cptr shm3=(lds_cptr)shm; const lds_cptr kp0=shm3+LDS_K+hi*1024+r32*16; const lds_cptr vp0=shm3+LDS_V+((lane>>4)&1)*32+(lane&3)*8+(4*hi+((lane&15)>>2))*64;
  const int NT=(q0+QB)/KVBLK;
  DMA_K(0,0);DMA_V(0,0);DMA_K(1,SLOTB);
  bf16x8 qr[4];
  #pragma unroll
  for(int d0=0;d0<4;++d0)qr[d0]=*reinterpret_cast<const bf16x8*>(&Qw[(long)r32*PQ+d0*16+hi*8]);
  float mhat=0.f,l_reg=0.f;f32x16 o[4];o[0]=f32x16{};o[1]=f32x16{};o[2]=f32x16{};o[3]=f32x16{};f32x16 negm=f32x16{};asm volatile("":"+v"(negm));
  const int qrel=wid*QBLK+r32;
  #define CMASK(P0,P1,t) do{int jb_=(t)-(NT-4); if(jb_>=0)cmask(P0,P1,jb_,wid);}while(0)
  bool resc=false;
  #define START(P0,P1) do{ const float rm=rowmax(P0,P1); resc=false; \
    { const float dl=rm; mhat=fadd_s(mhat,dl); \
      _Pragma("unroll") for(int r=0;r<16;++r){P0[r]=fsub_s(P0[r],dl);P1[r]=fsub_s(P1[r],dl);} \
      _Pragma("unroll") for(int r=0;r<16;++r)negm[r]=-mhat; asm volatile("":"+v"(negm)); } \
    _Pragma("unroll") for(int r=0;r<16;++r)P0[r]=__builtin_amdgcn_exp2f(P0[r]); }while(0)
  #define RESC() do{ if(resc){ asm volatile("s_waitcnt lgkmcnt(0)":::"memory"); \
      _Pragma("unroll") for(int d_=0;d_<4;++d_) _Pragma("unroll") for(int r=0;r<16;++r)o[d_][r]*=wsf[crow(r,hi)]; } }while(0)
  f32x16 pA0,pA1,pB0,pB1;
  int sl_prev=0,sl_cur=0,sl_next=SLOTB;
  #define ROT() do{sl_prev=sl_cur;sl_cur=sl_next;sl_next=(sl_next==(NSLOT-1)*SLOTB)?0:sl_next+SLOTB;}while(0)
  DMA_K(2,2*SLOTB);
  WAIT_BAR(3);
  qkt(pA0,pA1,Kbase,qr,negm,r32,hi);asm volatile("s_nop 15\n\ts_nop 7":"+v"(pA0),"+v"(pA1));CMASK(pA0,pA1,0);
  START(pA0,pA1);
  _Pragma("unroll") for(int r=0;r<16;++r)pA1[r]=__builtin_amdgcn_exp2f(pA1[r]);
  WAIT_BAR(0);
  DMA_K(3,0);DMA_V(1,SLOTB);
  ROT();
  kload8(kf,kp0+sl_cur);
  WAIT_BAR(3);
  s16x4 vlo[8],vhi[8]; u32x4 pw0,pw1,pw2,pw3;
  #define PKW(P,B) cvtpk_s(P[B],P[B+1])
  #define PAF(k) __builtin_bit_cast(bf16x8,pw##k)
  #define VFR(i) (bf16x8){vlo[i][0],vlo[i][1],vlo[i][2],vlo[i][3],vhi[i][0],vhi[i][1],vhi[i][2],vhi[i][3]}
  #define PIN(x) asm volatile("":"+v"(x))
  #define MX3(a,b,c) __builtin_fmaxf(__builtin_fmaxf((a),(b)),(c))
  #define GAPA(MF,A0,A1,A2,A3,W0,W1,PW) do{ MF; sacc+=A0; sacc+=A1; sacc+=A2; sacc+=A3; PIN(sacc); W0; W1; PIN(PW); SBAR(); }while(0)
  #define EX(v) __builtin_amdgcn_exp2f(v)
  #define GAPB(MF,X,B) do{ MF; X[B]=EX(X[B]); X[B+1]=EX(X[B+1]); PIN(X); SBAR(); }while(0)
  #define GAPB2(MF,X,B,i) do{ MF; VRD2(i); X[B]=EX(X[B]); X[B+1]=EX(X[B+1]); PIN(X); SBAR(); }while(0)
  #define VRD(i) do{ vlo[i]=vtr(vp_+(((i)>>2)*4096+((i)&3)*1024)); vhi[i]=vtr(vp_+(((i)>>2)*4096+((i)&3)*1024+512)); }while(0)
  #define VRD2(i) do{ vlo[i]=vtr(vp_+(8192+((i)>>2)*4096+((i)&3)*1024)); vhi[i]=vtr(vp_+(8192+((i)>>2)*4096+((i)&3)*1024+512)); }while(0)
  #define KRD(G,j) do{ if(G){ kload2(kf,kp0+sl_next,j); SBAR(); } }while(0)
  #define STEP(C0,C1,P0,P1,t,GK,GV,GL) do{ SBAR(); \
    const lds_cptr vp_=vp0+2*sl_prev; \
    VRD(0); SBAR(); float sacc=(P0[0]+P0[1]); \
    GAPA(C0=__builtin_amdgcn_mfma_f32_32x32x16_bf16(kf[0],qr[0],negm,0,0,0), P0[2],P0[3],P0[4],P0[5],     pw0[0]=PKW(P0,0), pw0[1]=PKW(P0,2), pw0); \
    VRD(4); SBAR(); GAPA(C1=__builtin_amdgcn_mfma_f32_32x32x16_bf16(kf[1],qr[0],negm,0,0,0), P0[6],P0[7],P0[8],P0[9],     pw0[2]=PKW(P0,4), pw0[3]=PKW(P0,6), pw0); \
    VRD(1); SBAR(); GAPA(C0=__builtin_amdgcn_mfma_f32_32x32x16_bf16(kf[2],qr[1],C0,0,0,0),   P0[10],P0[11],P0[12],P0[13], pw1[0]=PKW(P0,8), pw1[1]=PKW(P0,10), pw1); \
    VRD(5); SBAR(); GAPA(C1=__builtin_amdgcn_mfma_f32_32x32x16_bf16(kf[3],qr[1],C1,0,0,0),   P0[14],P0[15],P1[0],P1[1],   pw1[2]=PKW(P0,12),pw1[3]=PKW(P0,14), pw1); \
    VRD(2); SBAR(); GAPA(C0=__builtin_amdgcn_mfma_f32_32x32x16_bf16(kf[4],qr[2],C0,0,0,0),   P1[2],P1[3],P1[4],P1[5],     pw2[0]=PKW(P1,0), pw2[1]=PKW(P1,2), pw2); \
    VRD(6); SBAR(); GAPA(C1=__builtin_amdgcn_mfma_f32_32x32x16_bf16(kf[5],qr[2],C1,0,0,0),   P1[6],P1[7],P1[8],P1[9],     pw2[2]=PKW(P1,4), pw2[3]=PKW(P1,6), pw2); \
    VRD(3); SBAR(); GAPA(C0=__builtin_amdgcn_mfma_f32_32x32x16_bf16(kf[6],qr[3],C0,0,0,0),   P1[10],P1[11],P1[12],P1[13], pw3[0]=PKW(P1,8), pw3[1]=PKW(P1,10), pw3); \
    VRD(7); SBAR(); GAPA(C1=__builtin_amdgcn_mfma_f32_32x32x16_bf16(kf[7],qr[3],C1,0,0,0),   P1[14],P1[15],0.f,0.f,       pw3[2]=PKW(P1,12),pw3[3]=PKW(P1,14), pw3); \
    l_reg+=sacc; \
    if(GK){DMA_K((t)+3,sl_cur);} if(GV){DMA_V((t)+1,sl_next);} \
    CMASK(C0,C1,t); \
    { float a=MX3(C0[0],C0[1],C1[0]),b=MX3(C0[2],C0[3],C1[1]); a=MX3(a,C1[2],C1[3]); \
      _Pragma("unroll") for(int r=4;r<16;r+=4){a=MX3(a,C0[r],C0[r+1]);b=MX3(b,C0[r+2],C0[r+3]);a=MX3(a,C1[r],C1[r+1]);b=MX3(b,C1[r+2],C1[r+3]);} \
      float rm=__builtin_fmaxf(a,b); { auto rr=__builtin_amdgcn_permlane32_swap(__float_as_uint(rm),__float_as_uint(rm),false,false); rm=__builtin_fmaxf(__uint_as_float(rr[0]),__uint_as_float(rr[1])); } \
      resc=false; \
      if(__builtin_expect(__any(rm>(float)THRL),0)){ const float dl=__builtin_fmaxf(rm,0.f); mhat+=dl; \
        _Pragma("unroll") for(int r=0;r<16;++r){C0[r]-=dl;C1[r]-=dl;} \
        _Pragma("unroll") for(int r=0;r<16;++r)negm[r]=-mhat; asm volatile("":"+v"(negm)); \
        const float f=__builtin_amdgcn_exp2f(-dl); l_reg*=f; if(hi==0)wsf[r32]=f; resc=true; } } \
    SBAR(); \
    GAPB(o[0]=__builtin_amdgcn_mfma_f32_32x32x16_bf16(PAF(0),VFR(0),o[0],0,0,0), C0,0); \
    GAPB(o[1]=__builtin_amdgcn_mfma_f32_32x32x16_bf16(PAF(0),VFR(4),o[1],0,0,0), C0,2); \
    KRD(GL,0); GAPB(o[0]=__builtin_amdgcn_mfma_f32_32x32x16_bf16(PAF(1),VFR(1),o[0],0,0,0), C0,4); \
    KRD(GL,1); GAPB(o[1]=__builtin_amdgcn_mfma_f32_32x32x16_bf16(PAF(1),VFR(5),o[1],0,0,0), C0,6); \
    KRD(GL,2); GAPB2(o[0]=__builtin_amdgcn_mfma_f32_32x32x16_bf16(PAF(2),VFR(2),o[0],0,0,0), C0,8,0); \
    KRD(GL,3); GAPB2(o[1]=__builtin_amdgcn_mfma_f32_32x32x16_bf16(PAF(2),VFR(6),o[1],0,0,0), C0,10,4); \
    GAPB2(o[0]=__builtin_amdgcn_mfma_f32_32x32x16_bf16(PAF(3),VFR(3),o[0],0,0,0), C0,12,1); \
    GAPB2(o[1]=__builtin_amdgcn_mfma_f32_32x32x16_bf16(PAF(3),VFR(7),o[1],0,0,0), C0,14,5); \
      \
      \
    VRD2(2); VRD2(6); VRD2(3); VRD2(7); SBAR(); \
    GAPB(o[2]=__builtin_amdgcn_mfma_f32_32x32x16_bf16(PAF(0),VFR(0),o[2],0,0,0), C1,0); \
    GAPB(o[3]=__builtin_amdgcn_mfma_f32_32x32x16_bf16(PAF(0),VFR(4),o[3],0,0,0), C1,2); \
    GAPB(o[2]=__builtin_amdgcn_mfma_f32_32x32x16_bf16(PAF(1),VFR(1),o[2],0,0,0), C1,4); \
    GAPB(o[3]=__builtin_amdgcn_mfma_f32_32x32x16_bf16(PAF(1),VFR(5),o[3],0,0,0), C1,6); \
    GAPB(o[2]=__builtin_amdgcn_mfma_f32_32x32x16_bf16(PAF(2),VFR(2),o[2],0,0,0), C1,8); \
    GAPB(o[3]=__builtin_amdgcn_mfma_f32_32x32x16_bf16(PAF(2),VFR(6),o[3],0,0,0), C1,10); \
    GAPB(o[2]=__builtin_amdgcn_mfma_f32_32x32x16_bf16(PAF(3),VFR(3),o[2],0,0,0), C1,12); \
    GAPB(o[3]=__builtin_amdgcn_mfma_f32_32x32x16_bf16(PAF(3),VFR(7),o[3],0,0,0), C1,14); \
    }while(0)
  int t=1;
  #undef CMASK
  #define CMASK(P0,P1,t) do{}while(0)
  for(;t+5<NT;t+=2){
    STEP(pB0,pB1,pA0,pA1,t,true,true,true);     WAIT_BAR(3); RESC(); ROT();
    STEP(pA0,pA1,pB0,pB1,t+1,true,true,true);   WAIT_BAR(3); RESC(); ROT();
  }
  #undef CMASK
  #define CMASK(P0,P1,t) do{int jb_=(t)-(NT-4); if(jb_>=0)cmask(P0,P1,jb_,wid);}while(0)
  #define ENDW(tt) do{ if((tt)+3<NT){WAIT_BAR(3);} else if((tt)+2<NT){WAIT_BAR(2);} else {WAIT_BAR(0);} }while(0)
  for(;t+1<NT;t+=2){
    STEP(pB0,pB1,pA0,pA1,t,(t+3<NT),(t+1<NT),(t+1<NT));       ENDW(t);   RESC(); ROT();
    STEP(pA0,pA1,pB0,pB1,t+1,(t+4<NT),(t+2<NT),(t+2<NT));     ENDW(t+1); RESC(); ROT();
  }
  STEP(pB0,pB1,pA0,pA1,NT-1,false,false,false); RESC();
  { float sacc=pB0[0]+pB0[1]; _Pragma("unroll") for(int r=2;r<16;++r)sacc+=pB0[r]; _Pragma("unroll") for(int r=0;r<16;++r)sacc+=pB1[r]; l_reg+=sacc;
    pw0=(u32x4){PKW(pB0,0),PKW(pB0,2),PKW(pB0,4),PKW(pB0,6)};pw1=(u32x4){PKW(pB0,8),PKW(pB0,10),PKW(pB0,12),PKW(pB0,14)};pw2=(u32x4){PKW(pB1,0),PKW(pB1,2),PKW(pB1,4),PKW(pB1,6)};pw3=(u32x4){PKW(pB1,8),PKW(pB1,10),PKW(pB1,12),PKW(pB1,14)};
    SBAR(); pv(o,vb0+2*sl_cur,PAF(0),PAF(1),PAF(2),PAF(3)); pv(o+2,vb0+2*sl_cur+8192,PAF(0),PAF(1),PAF(2),PAF(3)); }
  #undef PKW
  #undef PAF
  #undef VFR
  #undef PIN
  #undef MX3
  #undef GAPA
  #undef GAPB
  #undef GAPB2
  #undef EX
  #undef VRD
  #undef VRD2
  #undef KRD
  #undef STEP
  #undef ENDW
  {auto rr=__builtin_amdgcn_permlane32_swap(__float_as_uint(l_reg),__float_as_uint(l_reg),false,false);l_reg=__uint_as_float(rr[0])+__uint_as_float(rr[1]);}
  if(hi==0)wsf[32+r32]=l_reg;asm volatile("s_waitcnt lgkmcnt(0)":::"memory");
  float rli[16];
  #pragma unroll
  for(int r=0;r<16;++r)rli[r]=__builtin_amdgcn_rcpf(wsf[32+crow(r,hi)]);
  bf16*Ow=O+(rowbase+q0+wid*QBLK)*PO+ocol;
  { bf16*stg=(bf16*)(shm+LDS_OST)+wid*2048;
    #pragma unroll
    for(int hf=0;hf<2;++hf){
      #pragma unroll
      for(int r=0;r<16;++r){const int orow=crow(r,hi);
        #pragma unroll
        for(int d0=0;d0<2;++d0)stg[orow*64+d0*32+r32]=__float2bfloat16(o[2*hf+d0][r]*rli[r]);}
      asm volatile("s_waitcnt lgkmcnt(0)":::"memory");
      #pragma unroll
      for(int i=0;i<4;++i){const int row=i*8+(lane>>3),ch=lane&7; const u32x4 v=*(const u32x4*)(stg+row*64+ch*8); ATTN_STORE16(Ow+(long)row*PO+hf*64+ch*8,v);}
      asm volatile("s_waitcnt lgkmcnt(0)":::"memory"); } }
  asm volatile("s_waitcnt lgkmcnt(0)\n\ts_barrier":::"memory");
  #undef DMA_K
  #undef DMA_V
  #undef CMASK
  #undef START
  #undef RESC
  #undef ROT
}
constexpr int ATTN_LDS_BYTES=LDS_BYTES;
#undef SBAR
#undef WAIT_BAR
}
#define LAS __attribute__((address_space(3)))
typedef unsigned short bf16_t;
typedef float f32x4 __attribute__((ext_vector_type(4)));
typedef unsigned u32x4 __attribute__((ext_vector_type(4)));
typedef unsigned u32x2 __attribute__((ext_vector_type(2)));

constexpr int NB = 4, SEQ = 4096, M = NB * SEQ, D = 1024, DIN = 3584, FF = 2816, DEPTH = 4;
constexpr int C_Q = 0, C_K = 512, C_V = 1024, C_HQ = 1536, C_F = 2048, C_I = 2560, C_G = 3072;
constexpr size_t MiB = 1u << 20;
constexpr size_t WS_WIN = 1 * MiB, WS_WOUT = 8 * MiB, WS_WGU = 10 * MiB, WS_WDN = 21 * MiB, WS_SS = 27 * MiB, WS_XG = 28 * MiB, WS_PROJ = 60 * MiB, WS_MIX = 172 * MiB, WS_ST = 204 * MiB, WS_END = 236 * MiB;
constexpr int NWAVES = 8, NTHR = 512, LDS_BYTES = 147456, MISC_OFF = 139264;
constexpr size_t WS_BAR = 768 * 1024, BAR_BYTES = 16384;
constexpr float NORM_EPS = 1e-6f, LOG2E = 1.4426950408889634f;
#ifndef HGRN_NAIVE
#define HGRN_NAIVE 0
#endif
#ifndef DUPMASK
#define DUPMASK 0
#endif
#define NREP(k) (((DUPMASK >> (k)) & 1) ? 2 : 1)
#ifndef PHMASK
#define PHMASK 255
#endif
constexpr int PH_PER_LAYER = 8, N_PHASES = DEPTH * PH_PER_LAYER;

__device__ __forceinline__ unsigned f2bf(float f) { unsigned u = __builtin_bit_cast(unsigned, f); return (u + 0x7fffu + ((u >> 16) & 1u)) >> 16; }
__device__ __forceinline__ unsigned pk2(float lo, float hi) { return f2bf(lo) | (f2bf(hi) << 16); }
__device__ __forceinline__ float bf2f(bf16_t b) { return __builtin_bit_cast(float, (unsigned)b << 16); }
__device__ __forceinline__ float bflo(unsigned w) { return __builtin_bit_cast(float, w << 16); }
__device__ __forceinline__ float bfhi(unsigned w) { return __builtin_bit_cast(float, w & 0xffff0000u); }
__device__ __forceinline__ float wave_sum(float v) {
#pragma unroll
    for (int o = 1; o < 64; o <<= 1) v += __shfl_xor(v, o);
    return v;
}
__device__ __forceinline__ float sigmoid_f(float v) { return __builtin_amdgcn_rcpf(1.f + __expf(-v)); }
__device__ __forceinline__ float silu_f(float v) { return v * sigmoid_f(v); }

__device__ __forceinline__ float row_rstd(const float* ss, int row, int fq) {
    const f32x4 v = *(const f32x4*)(ss + (size_t)row * 16 + fq * 4);
    float s = (v.x + v.y) + (v.z + v.w);
    s += __shfl_xor(s, 16); s += __shfl_xor(s, 32);
    return rsqrtf(s * (1.f / D) + NORM_EPS);
}

#define XB_TMO      128
#define XB_XCNT(j)  (256  + 64 * (j))
#define XB_XSUB(j)  (1280 + 64 * (j))
#define XB_XGEN(j)  (2304 + 64 * (j))
#define XB_TOP      3328
#define XB_TOPGEN   3392
#define XCD_BAR_WORDS 3456
#define XB_SPIN_CAP (1u << 18)

__device__ __forceinline__ unsigned xb_ld(unsigned* p)              { return __hip_atomic_load(p, __ATOMIC_RELAXED, __HIP_MEMORY_SCOPE_AGENT); }
__device__ __forceinline__ unsigned xb_add(unsigned* p, unsigned v) { return __hip_atomic_fetch_add(p, v, __ATOMIC_RELAXED, __HIP_MEMORY_SCOPE_AGENT); }
__device__ __forceinline__ unsigned xb_xcc_id() { return (unsigned)__builtin_amdgcn_s_getreg((3 << 11) | 20) & 0xFu; }
#define XB_SPIN(cond, bar) do { unsigned _sp = 0; while (cond) { __builtin_amdgcn_s_sleep(1); \
    if ((++_sp & 255u) == 0u) { if (xb_ld(&(bar)[XB_TMO])) break; if (_sp > XB_SPIN_CAP) { atomicAdd(&(bar)[XB_TMO], 1u); break; } } } } while (0)

struct XcdBarrier {
    unsigned* bar; unsigned x;
    volatile LAS unsigned* st;
};

__device__ __forceinline__ XcdBarrier xcd_barrier_post(unsigned* bar, volatile LAS unsigned* st) {
    XcdBarrier b; b.bar = bar; b.x = xb_xcc_id(); b.st = st;
    if (threadIdx.x == 0) (void)xb_add(&bar[XB_XCNT(b.x)], 1u);
    return b;
}
__device__ __forceinline__ void xcd_barrier_complete(unsigned* bar, unsigned x, unsigned& nloc, unsigned& nx) {
    const unsigned G = gridDim.x * gridDim.y * gridDim.z;
    unsigned sum, cnt, mine, sp = 0u;
    for (;;) {
        sum = 0u; cnt = 0u; mine = 0u;
#pragma unroll
        for (unsigned j = 0; j < 16; ++j) { const unsigned c = xb_ld(&bar[XB_XCNT(j)]); sum += c; cnt += (c > 0u) ? 1u : 0u; mine = (j == x) ? c : mine; }
        if (sum == G) break;
        __builtin_amdgcn_s_sleep(1);
        if ((++sp & 255u) == 0u) { if (xb_ld(&bar[XB_TMO])) break; if (sp > XB_SPIN_CAP) { atomicAdd(&bar[XB_TMO], 1u); break; } }
    }
    nloc = mine > 0u ? mine : 1u; nx = cnt > 0u ? cnt : 1u;
}

__device__ __forceinline__ void xcd_barrier(const XcdBarrier& b) {
    asm volatile("s_waitcnt vmcnt(0)" ::: "memory");
    __syncthreads();
    if (threadIdx.x == 0) {
        unsigned* bar = b.bar;
        __builtin_amdgcn_s_waitcnt(0);
        unsigned nloc = b.st[0], nx = b.st[1];
        if (nloc == 0u) { xcd_barrier_complete(bar, b.x, nloc, nx); b.st[0] = nloc; b.st[1] = nx; }
        const unsigned old = xb_add(&bar[XB_XSUB(b.x)], 1u);
        const unsigned gen = old / nloc;
        if (old + 1u == (gen + 1u) * nloc) {
            __builtin_amdgcn_fence(__ATOMIC_RELEASE, "agent");
            asm volatile("s_waitcnt vmcnt(0)" ::: "memory");
            const unsigned og = xb_add(&bar[XB_TOP], 1u);
            const unsigned tg = og / nx;
            if (og + 1u == (tg + 1u) * nx) xb_add(&bar[XB_TOPGEN], 1u);
            else XB_SPIN(xb_ld(&bar[XB_TOPGEN]) == tg, bar);
            __builtin_amdgcn_fence(__ATOMIC_ACQUIRE, "agent");
            xb_add(&bar[XB_XGEN(b.x)], 1u);
            asm volatile("s_waitcnt vmcnt(0)" ::: "memory");
        } else {
            XB_SPIN(xb_ld(&bar[XB_XGEN(b.x)]) == gen, bar);
            __builtin_amdgcn_fence(__ATOMIC_ACQUIRE, "agent");
            asm volatile("s_waitcnt vmcnt(0)" ::: "memory");
        }
    }
    __syncthreads();
}


constexpr int RSTD_OFF = 131072, LBT_OFF = 131072 + 1024, QKG_OFF = 131072 + 3072;
constexpr int XCH_A = QKG_OFF + 512, XCH_B = MISC_OFF + 64;
static_assert(XCH_A + 4096 <= MISC_OFF && XCH_B + 4096 <= LDS_BYTES, "LDS map above the GEMM stage region");
__device__ __forceinline__ void build_row_tables(LAS unsigned char* lds, const float* ss, int pm, const float* lbp, int layer, int tid, const float* qg = nullptr, const float* kg = nullptr) {
    { const int row = tid >> 1, half = tid & 1; const float* p = ss + (size_t)(pm * 256 + row) * 16 + half * 8;
      const f32x4 a = *(const f32x4*)p, b = *(const f32x4*)(p + 4);
      float s = ((a.x + a.y) + (a.z + a.w)) + ((b.x + b.y) + (b.z + b.w));
      s += __shfl_xor(s, 1);
      if (half == 0) ((LAS float*)(lds + RSTD_OFF))[row] = rsqrtf(s * (1.f / D) + NORM_EPS); }
    if (lbp && layer > 0) {
        const int c = tid;
        const float a0 = lbp[c], a1 = lbp[512 + c], a2 = lbp[1024 + c], a3 = lbp[1536 + c];
        const float mx = fmaxf(fmaxf(a0, a1), fmaxf(a2, a3));
        const float e0 = __expf(a0 - mx), e1 = __expf(a1 - mx), e2 = __expf(a2 - mx), e3 = __expf(a3 - mx);
        float cum = e1; if (layer >= 2) cum += e2; if (layer >= 3) cum += e3;
        ((LAS float*)(lds + LBT_OFF))[c] = cum / ((e0 + e1) + (e2 + e3));
    }
    if (qg && tid < 128) ((LAS float*)(lds + QKG_OFF))[tid] = (tid < 64) ? qg[tid] * (0.125f * LOG2E) : kg[tid - 64];
    __syncthreads();
}

template <bool TAB> struct EpiA {
    static constexpr bool PERM = true, AFTER_DRAIN = false;
    bf16_t* proj; const float* ss; const float* lbp; int layer; const LAS float* rtab; const LAS float* lbtab; LAS unsigned char* xlds;
    __device__ __forceinline__ void operator()(const pg8::f32x4 (&acc)[2][2][4][2], const pg8::Unit& u, int wr, int wc, int fr, int fq) const {
        const int seg = u.pn >> 1;
        const int row0 = u.pm * 256 + wr * 64 + fr, colb = u.pn * 256 + wc * 32 + 8 * fq;
        if constexpr (TAB) if (seg < 2) {
            typedef float f32x2e __attribute__((ext_vector_type(2)));
            float ps[2][4][2];
#pragma unroll
            for (int ai = 0; ai < 2; ++ai)
#pragma unroll
                for (int m = 0; m < 4; ++m) { const float rs0 = rtab[wr * 64 + fr + ai * 128 + m * 16];
#pragma unroll
                    for (int bj = 0; bj < 2; ++bj) { const pg8::f32x4 a0 = acc[ai][bj][m][0], a1 = acc[ai][bj][m][1];
                        float s = ((a0[0] * a0[0] + a0[1] * a0[1]) + (a0[2] * a0[2] + a0[3] * a0[3])) + ((a1[0] * a1[0] + a1[1] * a1[1]) + (a1[2] * a1[2] + a1[3] * a1[3]));
                        s += __shfl_xor(s, 16); s += __shfl_xor(s, 32); ps[ai][m][bj] = s * (rs0 * rs0); } }
            const int wv = wr * 4 + wc;
            LAS float* X = (LAS float*)(xlds + (wv < 4 ? XCH_A + wv * 1024 : XCH_B + (wv - 4) * 1024));
            const LAS float* Y = (const LAS float*)(xlds + ((wv ^ 1) < 4 ? XCH_A + (wv ^ 1) * 1024 : XCH_B + ((wv ^ 1) - 4) * 1024));
            if (fq == 0) {
#pragma unroll
                for (int ai = 0; ai < 2; ++ai)
#pragma unroll
                    for (int m = 0; m < 4; ++m)
#pragma unroll
                        for (int bj = 0; bj < 2; ++bj) X[((ai * 4 + m) * 2 + bj) * 16 + fr] = ps[ai][m][bj];
            }
            asm volatile("s_waitcnt lgkmcnt(0)\n\ts_barrier" ::: "memory");
            const LAS float* gp = (const LAS float*)(xlds + QKG_OFF) + seg * 64 + (wc & 1) * 32 + 8 * fq;
            const f32x4 g0 = *(const LAS f32x4*)gp, g1 = *(const LAS f32x4*)(gp + 4);
#pragma unroll
            for (int ai = 0; ai < 2; ++ai)
#pragma unroll
                for (int m = 0; m < 4; ++m) {
                    const int row = row0 + ai * 128 + m * 16; const float rs1 = rtab[wr * 64 + fr + ai * 128 + m * 16];
#pragma unroll
                    for (int bj = 0; bj < 2; ++bj) {
                        const float tot = ps[ai][m][bj] + Y[((ai * 4 + m) * 2 + bj) * 16 + fr];
                        const float r = rsqrtf(tot * (1.f / 64.f) + NORM_EPS) * rs1;
                        const pg8::f32x4 a0 = acc[ai][bj][m][0] * r * g0, a1 = acc[ai][bj][m][1] * r * g1;
                        u32x4 w; w.x = pg8::cvt_pk_bf16(a0[0], a0[1]); w.y = pg8::cvt_pk_bf16(a0[2], a0[3]); w.z = pg8::cvt_pk_bf16(a1[0], a1[1]); w.w = pg8::cvt_pk_bf16(a1[2], a1[3]);
                        *(u32x4*)(proj + (size_t)row * DIN + colb + bj * 128) = w;
                    }
                }
            return;
        }
        float lb[2][8];
#pragma unroll
        for (int bj = 0; bj < 2; ++bj)
#pragma unroll
            for (int j = 0; j < 8; ++j) lb[bj][j] = 0.f;
        if (seg == 4 && layer > 0) {
            if constexpr (TAB) {
#pragma unroll
                for (int bj = 0; bj < 2; ++bj) { const f32x4 t0 = *(const LAS f32x4*)(lbtab + colb + bj * 128 - C_F), t1 = *(const LAS f32x4*)(lbtab + colb + bj * 128 - C_F + 4);
#pragma unroll
                    for (int j = 0; j < 4; ++j) { lb[bj][j] = t0[j]; lb[bj][4 + j] = t1[j]; } }
            } else {
#pragma unroll
                for (int bj = 0; bj < 2; ++bj)
#pragma unroll
                    for (int j = 0; j < 8; ++j) {
                        const int c = colb + bj * 128 + j - C_F;
                        const float a0 = lbp[c], a1 = lbp[512 + c], a2 = lbp[1024 + c], a3 = lbp[1536 + c];
                        const float mx = fmaxf(fmaxf(a0, a1), fmaxf(a2, a3));
                        const float e0 = __expf(a0 - mx), e1 = __expf(a1 - mx), e2 = __expf(a2 - mx), e3 = __expf(a3 - mx);
                        float cum = e1; if (layer >= 2) cum += e2; if (layer >= 3) cum += e3;
                        lb[bj][j] = cum / ((e0 + e1) + (e2 + e3));
                    }
            }
        }
#pragma unroll
        for (int ai = 0; ai < 2; ++ai)
#pragma unroll
            for (int m = 0; m < 4; ++m) {
                const int row = row0 + ai * 128 + m * 16;
                float rstd; if constexpr (TAB) rstd = rtab[row - u.pm * 256]; else rstd = row_rstd(ss, row, fq);
#pragma unroll
                for (int bj = 0; bj < 2; ++bj) {
                    typedef float f32x2e __attribute__((ext_vector_type(2)));
                    f32x2e x2[4];
#pragma unroll
                    for (int q = 0; q < 4; ++q) { const pg8::f32x4 a = acc[ai][bj][m][q >> 1]; x2[q] = ((q & 1) ? (f32x2e){a[2], a[3]} : (f32x2e){a[0], a[1]}) * rstd; }
                    if (seg == 3 || seg == 6) {
#pragma unroll
                        for (int q = 0; q < 4; ++q) { const f32x2e t = x2[q] * (-LOG2E); f32x2e e; e.x = __builtin_amdgcn_exp2f(t.x); e.y = __builtin_amdgcn_exp2f(t.y);
                            const f32x2e d = e + 1.0f; f32x2e rc; rc.x = __builtin_amdgcn_rcpf(d.x); rc.y = __builtin_amdgcn_rcpf(d.y); x2[q] = x2[q] * rc; }
                    } else if (seg == 4) {
                        if (layer == 0) {
#pragma unroll
                            for (int q = 0; q < 4; ++q) { const f32x2e z = x2[q], t = __builtin_elementwise_abs(z) * (-LOG2E); f32x2e e; e.x = __builtin_amdgcn_exp2f(t.x); e.y = __builtin_amdgcn_exp2f(t.y);
                                const f32x2e d = e + 1.0f; f32x2e lg; lg.x = __builtin_amdgcn_logf(d.x); lg.y = __builtin_amdgcn_logf(d.y);
                                x2[q] = __builtin_elementwise_min(z, (f32x2e){0.f, 0.f}) - lg * 0.6931471805599453f; }
                        } else {
#pragma unroll
                            for (int q = 0; q < 4; ++q) { const f32x2e t = x2[q] * (-LOG2E); f32x2e e; e.x = __builtin_amdgcn_exp2f(t.x); e.y = __builtin_amdgcn_exp2f(t.y);
                                const f32x2e d = e + 1.0f; f32x2e rc; rc.x = __builtin_amdgcn_rcpf(d.x); rc.y = __builtin_amdgcn_rcpf(d.y);
                                const f32x2e l2 = (f32x2e){lb[bj][2 * q], lb[bj][2 * q + 1]}, a = l2 + (1.0f - l2) * rc; f32x2e lg; lg.x = __builtin_amdgcn_logf(a.x); lg.y = __builtin_amdgcn_logf(a.y);
                                x2[q] = lg * 0.6931471805599453f; }
                        }
                    }
                    u32x4 w; w.x = pg8::cvt_pk_bf16(x2[0].x, x2[0].y); w.y = pg8::cvt_pk_bf16(x2[1].x, x2[1].y); w.z = pg8::cvt_pk_bf16(x2[2].x, x2[2].y); w.w = pg8::cvt_pk_bf16(x2[3].x, x2[3].y);
                    *(u32x4*)(proj + (size_t)row * DIN + colb + bj * 128) = w;
                }
            }
    }
};
template <bool BASE_F32, bool LAST> struct EpiRes {
    static constexpr bool PERM = true, AFTER_DRAIN = false;
    const float* basef; bf16_t* xres; float* outf; float* ss;
    __device__ __forceinline__ void operator()(const pg8::f32x4 (&acc)[2][2][4][2], const pg8::Unit& u, int wr, int wc, int fr, int fq) const {
        const int row0 = u.pm * 256 + wr * 64 + fr, colb = u.pn * 256 + wc * 32 + 8 * fq;
#pragma unroll
        for (int ai = 0; ai < 2; ++ai)
#pragma unroll
            for (int m = 0; m < 4; ++m) {
                const int row = row0 + ai * 128 + m * 16; float s = 0.f;
#pragma unroll
                for (int bj = 0; bj < 2; ++bj) {
                    const size_t off = (size_t)row * D + colb + bj * 128;
                    f32x4 b0, b1;
                    if constexpr (BASE_F32) { b0 = __builtin_nontemporal_load((const f32x4*)(basef + off)); b1 = __builtin_nontemporal_load((const f32x4*)(basef + off + 4)); }
                    else { const u32x4 w = *(const u32x4*)(xres + off); b0 = (f32x4){bflo(w.x), bfhi(w.x), bflo(w.y), bfhi(w.y)}; b1 = (f32x4){bflo(w.z), bfhi(w.z), bflo(w.w), bfhi(w.w)}; }
                    const f32x4 v0 = acc[ai][bj][m][0] + b0, v1 = acc[ai][bj][m][1] + b1;
                    if constexpr (LAST) { *(f32x4*)(outf + off) = v0; *(f32x4*)(outf + off + 4) = v1; }
                    else {
                        s += (v0.x * v0.x + v0.y * v0.y) + (v0.z * v0.z + v0.w * v0.w) + (v1.x * v1.x + v1.y * v1.y) + (v1.z * v1.z + v1.w * v1.w);
                        u32x4 w; w.x = pg8::cvt_pk_bf16(v0.x, v0.y); w.y = pg8::cvt_pk_bf16(v0.z, v0.w); w.z = pg8::cvt_pk_bf16(v1.x, v1.y); w.w = pg8::cvt_pk_bf16(v1.z, v1.w);
                        *(u32x4*)(xres + off) = w; }
                }
                if constexpr (!LAST) { s += __shfl_xor(s, 16); s += __shfl_xor(s, 32); if (fq == 0) ss[(size_t)row * 16 + u.pn * 4 + wc] = s; }
            }
    }
};
template <bool TAB> struct EpiGU {
    static constexpr bool PERM = true, AFTER_DRAIN = false;
    bf16_t* h; const float* ss; const LAS float* rtab;
    __device__ __forceinline__ void operator()(const pg8::f32x4 (&acc)[2][2][4][2], const pg8::Unit& u, int wr, int wc, int fr, int fq) const {
        const int row0 = u.pm * 256 + wr * 64 + fr, col = u.pn * 128 + wc * 32 + 8 * fq;
#pragma unroll
        for (int ai = 0; ai < 2; ++ai)
#pragma unroll
            for (int m = 0; m < 4; ++m) {
                const int row = row0 + ai * 128 + m * 16;
                float rstd; if constexpr (TAB) rstd = rtab[row - u.pm * 256]; else rstd = row_rstd(ss, row, fq);
                const float nl = -rstd * LOG2E, r2 = rstd * rstd;
                typedef float f32x2e __attribute__((ext_vector_type(2)));
                f32x2e o2[4];
#pragma unroll
                for (int q = 0; q < 4; ++q) {
                    const pg8::f32x4 gq = acc[ai][0][m][q >> 1], uq = acc[ai][1][m][q >> 1];
                    const f32x2e g2 = (q & 1) ? (f32x2e){gq[2], gq[3]} : (f32x2e){gq[0], gq[1]}, u2 = (q & 1) ? (f32x2e){uq[2], uq[3]} : (f32x2e){uq[0], uq[1]};
                    const f32x2e t = g2 * nl; f32x2e e; e.x = __builtin_amdgcn_exp2f(t.x); e.y = __builtin_amdgcn_exp2f(t.y);
                    const f32x2e d = e + 1.0f; f32x2e rc; rc.x = __builtin_amdgcn_rcpf(d.x); rc.y = __builtin_amdgcn_rcpf(d.y);
                    o2[q] = ((g2 * u2) * r2) * rc;
                }
                u32x4 w; w.x = pg8::cvt_pk_bf16(o2[0].x, o2[0].y); w.y = pg8::cvt_pk_bf16(o2[1].x, o2[1].y); w.z = pg8::cvt_pk_bf16(o2[2].x, o2[2].y); w.w = pg8::cvt_pk_bf16(o2[3].x, o2[3].y);
                *(u32x4*)(h + (size_t)row * FF + col) = w;
            }
    }
};

__device__ __forceinline__ void convert_macro(const float* __restrict__ W, const float* __restrict__ gk, int K, int N, bf16_t* WT, int k0, int n0, int mode, LAS float* scr, int tid) {
    float r[32];
#pragma unroll
    for (int i = 0; i < 32; ++i) r[i] = __builtin_nontemporal_load(W + (size_t)(k0 + i * 2 + (tid >> 8)) * N + n0 + (tid & 255));
#pragma unroll
    for (int i = 0; i < 32; ++i) { const int k = i * 2 + (tid >> 8); scr[k * 257 + (tid & 255)] = r[i] * (gk ? gk[k0 + k] : 1.f); }
    __syncthreads();
    const int c = tid & 7;
#pragma unroll
    for (int j = 0; j < 4; ++j) {
        const int nn = (tid >> 3) + 64 * j, nb = n0 + 64 * j;
        const int drow = (mode == 0) ? nb + (tid >> 3) : (nb / 128) * 256 + (nb % 128) + (mode == 2 ? 128 : 0) + (tid >> 3);
        const LAS float* s = scr + (8 * c) * 257 + nn;
        u32x4 o; o.x = pk2(s[0], s[257]); o.y = pk2(s[514], s[771]); o.z = pk2(s[1028], s[1285]); o.w = pk2(s[1542], s[1799]);
        *(u32x4*)(WT + (size_t)drow * K + k0 + 8 * c) = o;
    }
    __syncthreads();
}
constexpr int CV_IN = 16 * 14, CV_OUT = 16 * 4, CV_G = 16 * 11, CV_DN = 44 * 4;

template <int R> __device__ __forceinline__ void prologue_rows(const float* xrow, bf16_t* xgrow, float* ssrow, int lane) {
    f32x4 v[R][4];
#pragma unroll
    for (int q = 0; q < R; ++q)
#pragma unroll
        for (int j = 0; j < 4; ++j) v[q][j] = __builtin_nontemporal_load((const f32x4*)(xrow + (size_t)q * D) + lane + 64 * j);
#pragma unroll
    for (int q = 0; q < R; ++q) {
        float s = 0.f;
#pragma unroll
        for (int j = 0; j < 4; ++j) { const f32x4 w = v[q][j]; s += (w.x * w.x + w.y * w.y) + (w.z * w.z + w.w * w.w);
            u32x2 o; o.x = pk2(w.x, w.y); o.y = pk2(w.z, w.w); ((u32x2*)(xgrow + (size_t)q * D))[lane + 64 * j] = o; }
        s = wave_sum(s);
        if (lane < 16) ssrow[q * 16 + lane] = (lane == 0) ? s : 0.f;
    }
}
template <int R> __device__ __forceinline__ void qknorm_rows(bf16_t* prow, const float* qg, const float* kg, int lane) {
    bf16_t* p = prow + lane * 16;
    u32x4 a[R], b[R];
#pragma unroll
    for (int q = 0; q < R; ++q) { a[q] = *(const u32x4*)(p + (size_t)q * DIN); b[q] = *(const u32x4*)(p + (size_t)q * DIN + 8); }
    const float* g = (lane < 32 ? qg : kg) + (lane & 3) * 16;
    float gv[16];
#pragma unroll
    for (int i = 0; i < 16; ++i) gv[i] = g[i];
#pragma unroll
    for (int q = 0; q < R; ++q) {
        float v[16];
#pragma unroll
        for (int i = 0; i < 4; ++i) { v[2 * i] = bflo(a[q][i]); v[2 * i + 1] = bfhi(a[q][i]); v[8 + 2 * i] = bflo(b[q][i]); v[8 + 2 * i + 1] = bfhi(b[q][i]); }
        float s = 0.f;
#pragma unroll
        for (int i = 0; i < 16; ++i) s += v[i] * v[i];
        s += __shfl_xor(s, 1); s += __shfl_xor(s, 2);
        const float r = rsqrtf(s * (1.f / 64.f) + NORM_EPS) * (lane < 32 ? 0.125f * LOG2E : 1.f);
        u32x4 oa, ob;
#pragma unroll
        for (int i = 0; i < 4; ++i) { oa[i] = pk2(v[2 * i] * r * gv[2 * i], v[2 * i + 1] * r * gv[2 * i + 1]); ob[i] = pk2(v[8 + 2 * i] * r * gv[8 + 2 * i], v[8 + 2 * i + 1] * r * gv[8 + 2 * i + 1]); }
        *(u32x4*)(p + (size_t)q * DIN) = oa; *(u32x4*)(p + (size_t)q * DIN + 8) = ob;
    }
}
template <int R> __device__ __forceinline__ void combine_rows(const bf16_t* Orow, bf16_t* mixrow, const float* subg, float lam, float oscale, int lane) {
    const int h = lane >> 4, d0 = (lane & 15) * 8;
    u32x4 a[R], b[R];
#pragma unroll
    for (int q = 0; q < R; ++q) { a[q] = *(const u32x4*)(Orow + (size_t)q * D + (2 * h) * 128 + d0); b[q] = *(const u32x4*)(Orow + (size_t)q * D + (2 * h + 1) * 128 + d0); }
    const f32x4 g0 = *(const f32x4*)(subg + d0), g1 = *(const f32x4*)(subg + d0 + 4);
    const float gv[8] = {g0.x, g0.y, g0.z, g0.w, g1.x, g1.y, g1.z, g1.w};
#pragma unroll
    for (int q = 0; q < R; ++q) {
        float v[8]; float s = 0.f;
#pragma unroll
        for (int i = 0; i < 4; ++i) { v[2 * i] = bflo(a[q][i]) - lam * bflo(b[q][i]); v[2 * i + 1] = bfhi(a[q][i]) - lam * bfhi(b[q][i]); }
#pragma unroll
        for (int i = 0; i < 8; ++i) s += v[i] * v[i];
        s += __shfl_xor(s, 1); s += __shfl_xor(s, 2); s += __shfl_xor(s, 4); s += __shfl_xor(s, 8);
        const float r = rsqrtf(s * (1.f / 128.f) + NORM_EPS) * oscale;
        u32x4 o;
#pragma unroll
        for (int i = 0; i < 4; ++i) o[i] = pk2(v[2 * i] * r * gv[2 * i], v[2 * i + 1] * r * gv[2 * i + 1]);
        *(u32x4*)(mixrow + (size_t)q * D + h * 128 + d0) = o;
    }
}
#if HGRN_NAIVE
__device__ __forceinline__ void hgrn_norm_row(bf16_t* mixrow, const bf16_t* projrow, const float* hg, int lane) {
    const int h = lane >> 4, d0 = (lane & 15) * 8;
    const u32x4 c = *(const u32x4*)(mixrow + 512 + h * 128 + d0), gg = *(const u32x4*)(projrow + C_G + h * 128 + d0);
    float v[8]; float s = 0.f;
#pragma unroll
    for (int i = 0; i < 4; ++i) { v[2 * i] = bflo(c[i]); v[2 * i + 1] = bfhi(c[i]); }
#pragma unroll
    for (int i = 0; i < 8; ++i) s += v[i] * v[i];
    s += __shfl_xor(s, 1); s += __shfl_xor(s, 2); s += __shfl_xor(s, 4); s += __shfl_xor(s, 8);
    const float r = rsqrtf(s * (1.f / 128.f) + NORM_EPS);
    u32x4 o;
#pragma unroll
    for (int i = 0; i < 4; ++i) o[i] = pk2(v[2 * i] * r * hg[d0 + 2 * i] * bflo(gg[i]), v[2 * i + 1] * r * hg[d0 + 2 * i + 1] * bfhi(gg[i]));
    *(u32x4*)(mixrow + 512 + h * 128 + d0) = o;
}
#endif
__device__ __forceinline__ void hgrn_naive(LAS float* sm, const bf16_t* proj, bf16_t* mix, int bh, int tid) {
    const int b = bh >> 2, h = bh & 3;
    LAS float* sf = sm; LAS float* sk = sm + 2048; LAS float* sq = sm + 4096; LAS float* sv = sm + 6144; LAS float* so = sm + 8192;
    const int v = tid & 127, kq = tid >> 7;
    float S[32];
#pragma unroll
    for (int j = 0; j < 32; ++j) S[j] = 0.f;
    for (int t0 = 0; t0 < SEQ; t0 += 16) {
        for (int e = tid; e < 2048; e += NTHR) { const int tt = e >> 7, k = e & 127; const bf16_t* r = proj + (size_t)(b * SEQ + t0 + tt) * DIN + h * 128 + k;
            const float lf = bf2f(r[C_F]); sf[e] = __expf(lf); sk[e] = -expm1f(lf); sq[e] = bf2f(r[C_HQ]); sv[e] = bf2f(r[C_I]); }
        __syncthreads();
        for (int tt = 0; tt < 16; ++tt) { float acc = 0.f; const float vv = sv[tt * 128 + v];
#pragma unroll
            for (int j = 0; j < 32; ++j) { const int k = tt * 128 + kq * 32 + j; S[j] = sf[k] * S[j] + sk[k] * vv; acc += sq[k] * S[j]; }
            so[(tt * 4 + kq) * 128 + v] = acc; }
        __syncthreads();
        for (int e = tid; e < 2048; e += NTHR) { const int tt = e >> 7, vc = e & 127;
            const float o = (so[(tt * 4 + 0) * 128 + vc] + so[(tt * 4 + 1) * 128 + vc]) + (so[(tt * 4 + 2) * 128 + vc] + so[(tt * 4 + 3) * 128 + vc]);
            mix[(size_t)(b * SEQ + t0 + tt) * D + 512 + h * 128 + vc] = (bf16_t)f2bf(o); }
    }
    __syncthreads();
}


typedef short hbf16x8 __attribute__((ext_vector_type(8)));
typedef float hf32x16 __attribute__((ext_vector_type(16)));
constexpr int HS_K = 272, HS_V = 144;
constexpr int HL_BF = 0, HL_QD = 32768, HL_KD = HL_QD + 64 * HS_K, HL_KO = HL_KD + 64 * HS_K, HL_QE = HL_KO + 32 * HS_K, HL_VT = HL_QE + 32 * HS_K, HL_KT = HL_VT + 128 * HS_V,
              HL_TOT = HL_KT + 128 * HS_V, HL_PART = HL_TOT + 2048, HL_END = HL_PART + 1024;
static_assert(HL_END <= 131072, "HGRN LDS map");
__device__ __forceinline__ int crow16(int r, int hi) { return (r & 3) + 8 * (r >> 2) + 4 * hi; }

__device__ __forceinline__ void hgrn_load1(const bf16_t* proj, int b, int h, int ch, int tid, unsigned short (&lr)[16], unsigned short (&vr)[16]) {
    const int col = tid & 127, seg = tid >> 7;
    const bf16_t* base = proj + (size_t)(b * SEQ + ch * 64 + seg * 16) * DIN + h * 128 + col;
#pragma unroll
    for (int i = 0; i < 16; ++i) { lr[i] = base[(size_t)i * DIN + C_F]; vr[i] = base[(size_t)i * DIN + C_I]; }
}
__device__ __forceinline__ void hgrn_pass1(LAS unsigned char* L, int tid, const unsigned short (&lr)[16], const unsigned short (&vr)[16], float (&cum)[16], float (&lf)[16], float& blast) {
    const int col = tid & 127, seg = tid >> 7;
    float cs = 0.f;
#pragma unroll
    for (int i = 0; i < 16; ++i) { lf[i] = bf2f(lr[i]); cs += lf[i]; cum[i] = cs; }
    LAS float* TOT = (LAS float*)(L + HL_TOT);
    TOT[seg * 128 + col] = cs;
    { u32x4 w0, w1;
#pragma unroll
      for (int i = 0; i < 4; ++i) { w0[i] = (unsigned)vr[2 * i] | ((unsigned)vr[2 * i + 1] << 16); w1[i] = (unsigned)vr[8 + 2 * i] | ((unsigned)vr[8 + 2 * i + 1] << 16); }
      LAS unsigned char* vp = L + HL_VT + col * HS_V + seg * 32;
      *(LAS u32x4*)vp = w0; *(LAS u32x4*)(vp + 16) = w1; }
    __syncthreads();
    const float t0 = TOT[col], t1 = TOT[128 + col], t2 = TOT[256 + col], t3 = TOT[384 + col];
    const float off = (seg > 0 ? t0 : 0.f) + (seg > 1 ? t1 : 0.f) + (seg > 2 ? t2 : 0.f);
    blast = (t0 + t1) + (t2 + t3);
#pragma unroll
    for (int i = 0; i < 16; ++i) cum[i] += off;
}
__device__ __forceinline__ void hgrn_stage1(LAS unsigned char* L, const bf16_t* proj, bf16_t* ST, float* Dbuf, int item, int tid) {
    const int bh = item >> 6, ch = item & 63, b = bh >> 2, h = bh & 3, col = tid & 127, seg = tid >> 7;
    const int lane = tid & 63, wave = __builtin_amdgcn_readfirstlane(tid >> 6), r = lane & 31, hh = lane >> 5;
    float cum[16], lf[16], blast;
    { unsigned short lr[16], vr[16]; hgrn_load1(proj, b, h, ch, tid, lr, vr); hgrn_pass1(L, tid, lr, vr, cum, lf, blast); }
    { u32x4 w0, w1; float ke[16];
#pragma unroll
      for (int i = 0; i < 16; ++i) ke[i] = (1.f - __expf(lf[i])) * __expf(blast - cum[i]);
#pragma unroll
      for (int i = 0; i < 4; ++i) { w0[i] = pk2(ke[2 * i], ke[2 * i + 1]); w1[i] = pk2(ke[8 + 2 * i], ke[8 + 2 * i + 1]); }
      LAS unsigned char* kp = L + HL_KT + col * HS_V + seg * 32;
      *(LAS u32x4*)kp = w0; *(LAS u32x4*)(kp + 16) = w1;
      if (seg == 0) Dbuf[(size_t)item * 128 + col] = __expf(blast); }
    __syncthreads();
    const int vb = wave & 3;
#pragma unroll
    for (int q = 0; q < 2; ++q) {
        const int kb = (wave >> 2) * 2 + q;
        hf32x16 acc = {};
        const LAS unsigned char* ap = L + HL_VT + (vb * 32 + r) * HS_V + hh * 16;
        const LAS unsigned char* bp = L + HL_KT + (kb * 32 + r) * HS_V + hh * 16;
#pragma unroll
        for (int s0 = 0; s0 < 4; ++s0) acc = __builtin_amdgcn_mfma_f32_32x32x16_bf16(*(const LAS hbf16x8*)(ap + s0 * 32), *(const LAS hbf16x8*)(bp + s0 * 32), acc, 0, 0, 0);
        bf16_t* out = ST + ((size_t)item * 128 + vb * 32) * 128 + kb * 32 + r;
#pragma unroll
        for (int g = 0; g < 16; ++g) out[(size_t)crow16(g, hh) * 128] = (bf16_t)f2bf(acc[g]);
    }
    __syncthreads();
}
typedef float hf32x2 __attribute__((ext_vector_type(2)));
__device__ __forceinline__ void hgrn_scan_row(bf16_t* ST, const float* Dbuf, int rowid, int lane) {
    const int bh = rowid >> 7, v = rowid & 127;
    unsigned* sp = (unsigned*)(ST + ((size_t)(bh * 64) * 128 + v) * 128) + lane;
    const hf32x2* dp = (const hf32x2*)(Dbuf + (size_t)(bh * 64) * 128) + lane;
    float s0 = 0.f, s1 = 0.f;
    for (int c0 = 0; c0 < 64; c0 += 16) {
        unsigned u[16]; hf32x2 d[16];
#pragma unroll
        for (int i = 0; i < 16; ++i) { u[i] = sp[(size_t)(c0 + i) * 8192]; d[i] = dp[(c0 + i) * 64]; }
#pragma unroll
        for (int i = 0; i < 16; ++i) { sp[(size_t)(c0 + i) * 8192] = pk2(s0, s1); s0 = d[i].x * s0 + bflo(u[i]); s1 = d[i].y * s1 + bfhi(u[i]); }
    }
}
__device__ __forceinline__ void hgrn_stage3(LAS unsigned char* L, const bf16_t* proj, const bf16_t* ST, bf16_t* mix, const float* hg, int item, int tid) {
    const int bh = item >> 6, ch = item & 63, b = bh >> 2, h = bh & 3, col = tid & 127, seg = tid >> 7;
    const int lane = tid & 63, wave = __builtin_amdgcn_readfirstlane(tid >> 6), r = lane & 31, hh = lane >> 5;
    const int vb = wave & 3, tb = wave >> 2;
    unsigned short lr[16], vr[16];
    hgrn_load1(proj, b, h, ch, tid, lr, vr);
    u32x4 qw2[2], fw2[2];
#pragma unroll
    for (int half = 0; half < 2; ++half) { const bf16_t* rowp = proj + (size_t)(b * SEQ + ch * 64 + (tid >> 4) + 32 * half) * DIN + h * 128 + (tid & 15) * 8;
        qw2[half] = *(const u32x4*)(rowp + C_HQ); fw2[half] = *(const u32x4*)(rowp + C_F); }
    hbf16x8 sfr[8];
    { const bf16_t* sg = ST + ((size_t)item * 128 + vb * 32 + r) * 128 + hh * 8;
#pragma unroll
      for (int kk = 0; kk < 8; ++kk) sfr[kk] = *(const hbf16x8*)(sg + kk * 16); }
    u32x2 gate2[4];
#pragma unroll
    for (int g = 0; g < 4; ++g) gate2[g] = *(const u32x2*)(proj + (size_t)(b * SEQ + ch * 64 + tb * 32 + r) * DIN + C_G + h * 128 + vb * 32 + 8 * g + 4 * hh);
    {
        float cum[16], lf[16], blast;
        hgrn_pass1(L, tid, lr, vr, cum, lf, blast);
        LAS float* BF = (LAS float*)(L + HL_BF);
#pragma unroll
        for (int i = 0; i < 16; ++i) BF[(seg * 16 + i) * 128 + col] = cum[i];
    }
    __syncthreads();
    {
        const int kvec = tid & 15;
        const LAS float* BF = (const LAS float*)(L + HL_BF);
        float b31[8];
        { const f32x4 x0 = *(const LAS f32x4*)(BF + 31 * 128 + kvec * 8), x1 = *(const LAS f32x4*)(BF + 31 * 128 + kvec * 8 + 4);
#pragma unroll
          for (int j = 0; j < 4; ++j) { b31[j] = x0[j]; b31[4 + j] = x1[j]; } }
#pragma unroll
        for (int half = 0; half < 2; ++half) {
            const int t = (tid >> 4) + 32 * half;
            const u32x4 qw = qw2[half], fw = fw2[half];
            const f32x4 y0 = *(const LAS f32x4*)(BF + t * 128 + kvec * 8), y1 = *(const LAS f32x4*)(BF + t * 128 + kvec * 8 + 4);
            float qd[8], kd[8], xx[8];
#pragma unroll
            for (int j = 0; j < 8; ++j) {
                const float q = (j & 1) ? bfhi(qw[j >> 1]) : bflo(qw[j >> 1]), lfj = (j & 1) ? bfhi(fw[j >> 1]) : bflo(fw[j >> 1]);
                const float bb = (j < 4) ? y0[j & 3] : y1[j & 3], kk = 1.f - __expf(lfj);
                const float rr = half ? b31[j] : 0.f;
                qd[j] = q * __expf(bb - rr); kd[j] = kk * __expf(fminf(rr - bb, 85.f));
                xx[j] = half ? q * __expf(bb) : kk * __expf(b31[j] - bb);
            }
            u32x4 w;
#pragma unroll
            for (int i = 0; i < 4; ++i) w[i] = pk2(qd[2 * i], qd[2 * i + 1]);
            *(LAS u32x4*)(L + HL_QD + t * HS_K + kvec * 16) = w;
#pragma unroll
            for (int i = 0; i < 4; ++i) w[i] = pk2(kd[2 * i], kd[2 * i + 1]);
            *(LAS u32x4*)(L + HL_KD + t * HS_K + kvec * 16) = w;
#pragma unroll
            for (int i = 0; i < 4; ++i) w[i] = pk2(xx[2 * i], xx[2 * i + 1]);
            *(LAS u32x4*)(L + (half ? HL_QE : HL_KO) + (t & 31) * HS_K + kvec * 16) = w;
        }
    }
    __syncthreads();
    hf32x16 o = {};
    for (int sb = 0; sb <= tb; ++sb) {
        hf32x16 X = {};
        const LAS unsigned char* ap = (sb == tb) ? (L + HL_KD + (sb * 32 + r) * HS_K + hh * 16) : (L + HL_KO + r * HS_K + hh * 16);
        const LAS unsigned char* bp = L + HL_QD + (tb * 32 + r) * HS_K + hh * 16;
#pragma unroll
        for (int kk = 0; kk < 8; ++kk) X = __builtin_amdgcn_mfma_f32_32x32x16_bf16(*(const LAS hbf16x8*)(ap + kk * 32), *(const LAS hbf16x8*)(bp + kk * 32), X, 0, 0, 0);
        if (sb == tb) {
#pragma unroll
            for (int g = 0; g < 16; ++g) if (crow16(g, hh) > r) X[g] = 0.f;
        }
#pragma unroll
        for (int sp = 0; sp < 2; ++sp) {
            u32x4 pw;
#pragma unroll
            for (int i = 0; i < 4; ++i) pw[i] = pk2(X[8 * sp + 2 * i], X[8 * sp + 2 * i + 1]);
            const LAS unsigned char* vp = L + HL_VT + (vb * 32 + r) * HS_V + (sb * 32 + 16 * sp + 4 * hh) * 2;
            const u32x2 lo = *(const LAS u32x2*)vp, hi = *(const LAS u32x2*)(vp + 16);
            u32x4 aw; aw.x = lo.x; aw.y = lo.y; aw.z = hi.x; aw.w = hi.y;
            o = __builtin_amdgcn_mfma_f32_32x32x16_bf16(__builtin_bit_cast(hbf16x8, aw), __builtin_bit_cast(hbf16x8, pw), o, 0, 0, 0);
        }
    }
    {
        const LAS unsigned char* qb = L + (tb ? HL_QE : HL_QD) + r * HS_K + hh * 16;
#pragma unroll
        for (int kk = 0; kk < 8; ++kk) o = __builtin_amdgcn_mfma_f32_32x32x16_bf16(sfr[kk], *(const LAS hbf16x8*)(qb + kk * 32), o, 0, 0, 0);
    }
    LAS float* PART = (LAS float*)(L + HL_PART);
    { float sq = 0.f;
#pragma unroll
      for (int g = 0; g < 16; ++g) sq += o[g] * o[g];
      sq += __shfl_xor(sq, 32);
      if (hh == 0) PART[vb * 64 + tb * 32 + r] = sq; }
    __syncthreads();
    {
        const int t = tb * 32 + r;
        const float tot = (PART[t] + PART[64 + t]) + (PART[128 + t] + PART[192 + t]);
        const float rstd = rsqrtf(tot * (1.f / 128.f) + NORM_EPS);
        const size_t row = (size_t)(b * SEQ + ch * 64 + t);
#pragma unroll
        for (int g = 0; g < 4; ++g) {
            const int v0 = vb * 32 + 8 * g + 4 * hh;
            const u32x2 gate = gate2[g]; const f32x4 gn = *(const f32x4*)(hg + v0);
            u32x2 w; w.x = pk2(o[4 * g] * rstd * gn.x * bflo(gate.x), o[4 * g + 1] * rstd * gn.y * bfhi(gate.x)); w.y = pk2(o[4 * g + 2] * rstd * gn.z * bflo(gate.y), o[4 * g + 3] * rstd * gn.w * bfhi(gate.y));
            *(u32x2*)(mix + row * D + 512 + h * 128 + v0) = w;
        }
    }
    __syncthreads();
}

struct Params { const float* in[17]; float* out; unsigned char* ws; int ph_lo, ph_hi; };
enum { I_X = 0, I_ATTN_G, I_WIN, I_QG, I_KG, I_LQ1, I_LK1, I_LQ2, I_LK2, I_SUBG, I_LB, I_HG, I_WOUT, I_FFN_G, I_WGATE, I_WUP, I_WDOWN };

__global__ void __launch_bounds__(NTHR, 2) fwd_megakernel(Params p) {
    extern __shared__ __attribute__((aligned(16))) unsigned char lds[];
    cg::grid_group grid = cg::this_grid();
    const int G = gridDim.x, bx = blockIdx.x;
    const int vcu = (G % 8 == 0) ? (bx % 8) * (G / 8) + bx / 8 : bx;
    const int NGW = G * NWAVES;
    unsigned char* ws = p.ws;
    bf16_t* win_t = (bf16_t*)(ws + WS_WIN); bf16_t* wout_t = (bf16_t*)(ws + WS_WOUT); bf16_t* wgu_t = (bf16_t*)(ws + WS_WGU); bf16_t* wdn_t = (bf16_t*)(ws + WS_WDN);
    float* ss = (float*)(ws + WS_SS); bf16_t* xg = (bf16_t*)(ws + WS_XG); bf16_t* Obuf = (bf16_t*)p.out;     bf16_t* proj = (bf16_t*)(ws + WS_PROJ); bf16_t* hbuf = proj; bf16_t* mix = (bf16_t*)(ws + WS_MIX); bf16_t* stbuf = (bf16_t*)(ws + WS_ST); float* dbuf = (float*)ws;
    LAS unsigned char* ldsl = (LAS unsigned char*)lds;
    volatile LAS unsigned* MISC = (volatile LAS unsigned*)(ldsl + MISC_OFF);
    if (threadIdx.x < 4) MISC[threadIdx.x] = 0u;
    __syncthreads();
    XcdBarrier xbar = xcd_barrier_post((unsigned*)(ws + WS_BAR), MISC);

    for (int ph = p.ph_lo; ph < p.ph_hi; ++ph) {
        if (ph % PH_PER_LAYER == 0 && ph > 0) continue;
        if (ph > p.ph_lo) {
            if (p.ph_hi > N_PHASES) grid.sync();
            xcd_barrier(xbar); if (DUPMASK & 256) xcd_barrier(xbar); }
        const int l = ph / PH_PER_LAYER, k = ph % PH_PER_LAYER;
        int tid = threadIdx.x; asm volatile("" : "+v"(tid));
        int Gl = G; asm volatile("" : "+s"(Gl));
        const int lane = tid & 63, wave = __builtin_amdgcn_readfirstlane(tid >> 6), gw = vcu * NWAVES + wave;
        if (k == 0 && (PHMASK & 1)) {
            LAS float* scr = (LAS float*)ldsl;
            for (int rep = 0; rep < NREP(0); ++rep)
            for (int it = bx; it < CV_IN + CV_OUT; it += G) {
                if (it < CV_IN) convert_macro(p.in[I_WIN], p.in[I_ATTN_G], D, DIN, win_t, (it / 14) * 64, (it % 14) * 256, 0, scr, tid);
                else { const int r = it - CV_IN; convert_macro(p.in[I_WOUT], nullptr, D, D, wout_t, (r / 4) * 64, (r % 4) * 256, 0, scr, tid); }
            }
            for (int m = gw * 4; m < M; m += NGW * 4) prologue_rows<4>(p.in[I_X] + (size_t)m * D, xg + (size_t)m * D, ss + (size_t)m * 16, lane);
        } else if (k == 1 && (PHMASK & 2)) {
            const int remA = ((M / 256) * (DIN / 256)) % G, firstA = remA ? remA : 0, nconvA = remA ? G - remA : G;
            const int nmyA = (bx >= firstA) ? (2 * CV_G - (bx - firstA) + nconvA - 1) / nconvA : 0, npreA = nmyA;
            { LAS float* scr = (LAS float*)ldsl;
              for (int j = 0; j < npreA; ++j) {
                  int r = bx - firstA + j * nconvA;
                  if (r < CV_G) { convert_macro(p.in[I_WGATE] + (size_t)l * D * FF, p.in[I_FFN_G] + l * D, D, FF, wgu_t, (r / 11) * 64, (r % 11) * 256, 1, scr, tid); continue; } r -= CV_G;
                  if (r < CV_G) { convert_macro(p.in[I_WUP] + (size_t)l * D * FF, p.in[I_FFN_G] + l * D, D, FF, wgu_t, (r / 11) * 64, (r % 11) * 256, 2, scr, tid); continue; } r -= CV_G;
                  convert_macro(p.in[I_WDOWN] + (size_t)l * FF * D, nullptr, FF, D, wdn_t, (r / 4) * 64, (r % 4) * 256, 0, scr, tid);
              } }
            pg8::Gemm g{xg, win_t, M, DIN, D}; pg8::StaticOrder S; S.init(M, DIN, G, bx);
            if (Gl == 256) {
                pg8::Unit u0; S.next(0, u0); build_row_tables(ldsl, ss, u0.pm, p.in[I_LB], l, tid, p.in[I_QG] + l * 64, p.in[I_KG] + l * 64);
                EpiA<true> E{proj, ss, p.in[I_LB], l, (const LAS float*)(ldsl + RSTD_OFF), (const LAS float*)(ldsl + LBT_OFF), ldsl};
                for (int rep = 0; rep < NREP(1); ++rep) pg8::gemm_phase<EpiA<true>, pg8::StaticOrder, true, true>(ldsl, g, S, E);
            } else {
                EpiA<false> E{proj, ss, p.in[I_LB], l, nullptr, nullptr, nullptr};
                pg8::gemm_phase<EpiA<false>, pg8::StaticOrder, true, true>(ldsl, g, S, E);
            }
            { LAS float* scr = (LAS float*)ldsl;
              for (int j = npreA; j < nmyA; ++j) {
                  int r = bx - firstA + j * nconvA;
                  if (r < CV_G) { convert_macro(p.in[I_WGATE] + (size_t)l * D * FF, p.in[I_FFN_G] + l * D, D, FF, wgu_t, (r / 11) * 64, (r % 11) * 256, 1, scr, tid); continue; } r -= CV_G;
                  if (r < CV_G) { convert_macro(p.in[I_WUP] + (size_t)l * D * FF, p.in[I_FFN_G] + l * D, D, FF, wgu_t, (r / 11) * 64, (r % 11) * 256, 2, scr, tid); continue; } r -= CV_G;
                  convert_macro(p.in[I_WDOWN] + (size_t)l * FF * D, nullptr, FF, D, wdn_t, (r / 4) * 64, (r % 4) * 256, 0, scr, tid);
              } }
        } else if (k == 2 && (PHMASK & 4)) {
#if HGRN_NAIVE
            if (bx < 16) hgrn_naive((LAS float*)ldsl, proj, mix, bx, tid);
            else for (int m = ((bx - 16) * NWAVES + wave) * 4; m < M; m += (G - 16) * NWAVES * 4) qknorm_rows<4>(proj + (size_t)m * DIN, p.in[I_QG] + l * 64, p.in[I_KG] + l * 64, lane);
#else
            if (Gl != 256) for (int m = gw * 8; m < M; m += NGW * 8) qknorm_rows<8>(proj + (size_t)m * DIN, p.in[I_QG] + l * 64, p.in[I_KG] + l * 64, lane);
            for (int rep = 0; rep < NREP(2); ++rep)
            for (int it = vcu; it < 1024; it += G) hgrn_stage1(ldsl, proj, stbuf, dbuf, it, tid);
#endif
        } else if (k == 3 && (PHMASK & 8)) {
            for (int rep = 0; rep < NREP(3); ++rep)
            for (int it = vcu; it < 256; it += G) {
                const int bq = it >> 3, s = it & 7, b = bq >> 3, qh = bq & 7, h = qh >> 1;
                for (int j = 0; j < 2; ++j) {
                    attn_body::attn_unit<8>(b, C_Q + qh * 64, C_K + qh * 64, C_V + h * 128, qh * 128, j ? s : 15 - s, (const attn_body::bf16*)proj, (attn_body::bf16*)Obuf, (char*)lds);
#if !HGRN_NAIVE
                    if (j == 0 && it == vcu) { int t2 = threadIdx.x; asm volatile("" : "+v"(t2));
                        const int wv2 = __builtin_amdgcn_readfirstlane(t2 >> 6);
                        for (int rowid = vcu * NWAVES + wv2; rowid < 16 * 128; rowid += NGW) hgrn_scan_row(stbuf, dbuf, rowid, t2 & 63); }
#endif
                }
            }
#if !HGRN_NAIVE
            if (vcu >= 256) for (int rowid = gw; rowid < 16 * 128; rowid += NGW) hgrn_scan_row(stbuf, dbuf, rowid, lane);
#endif
        } else if (k == 4 && (PHMASK & 16)) {
            const float li = 0.8f - 0.6f * expf(-0.3f * (float)l);
            const float d1 = wave_sum(p.in[I_LQ1][l * 64 + lane] * p.in[I_LK1][l * 64 + lane]), d2 = wave_sum(p.in[I_LQ2][l * 64 + lane] * p.in[I_LK2][l * 64 + lane]);
            const float lam = expf(d1) - expf(d2) + li;
#if !HGRN_NAIVE
            for (int rep = 0; rep < NREP(4); ++rep)
            for (int it = vcu; it < 1024; it += G) hgrn_stage3(ldsl, proj, stbuf, mix, p.in[I_HG] + l * 128, it, tid);
#endif
            for (int rep = 0; rep < NREP(5); ++rep)
            for (int m = gw * 8; m < M; m += NGW * 8) combine_rows<8>(Obuf + (size_t)m * D, mix + (size_t)m * D, p.in[I_SUBG] + l * 128, lam, 1.f - li, lane);
#if HGRN_NAIVE
            for (int m = gw; m < M; m += NGW) hgrn_norm_row(mix + (size_t)m * D, proj + (size_t)m * DIN, p.in[I_HG] + l * 128, lane);
#endif
        } else if (k == 6 && (PHMASK & 64)) {
            if (l + 1 < DEPTH) {
                const int remD = ((M / 256) * (2 * FF / 256)) % G, firstD = remD ? remD : 0, nconvD = remD ? G - remD : G;
                if (bx >= firstD) { LAS float* scr = (LAS float*)ldsl;
                    for (int it = bx - firstD; it < CV_IN + CV_OUT; it += nconvD) {
                        if (it < CV_IN) convert_macro(p.in[I_WIN] + (size_t)(l + 1) * D * DIN, p.in[I_ATTN_G] + (l + 1) * D, D, DIN, win_t, (it / 14) * 64, (it % 14) * 256, 0, scr, tid);
                        else { const int r = it - CV_IN; convert_macro(p.in[I_WOUT] + (size_t)(l + 1) * D * D, nullptr, D, D, wout_t, (r / 4) * 64, (r % 4) * 256, 0, scr, tid); }
                    } }
            }
            pg8::Gemm g{xg, wgu_t, M, 2 * FF, D}; pg8::StaticOrder S; S.init(M, 2 * FF, G, bx);
            if (Gl == 256) {
                pg8::Unit u0; S.next(0, u0); build_row_tables(ldsl, ss, u0.pm, nullptr, 0, tid);
                EpiGU<true> E{hbuf, ss, (const LAS float*)(ldsl + RSTD_OFF)};
                for (int rep = 0; rep < NREP(6); ++rep) pg8::gemm_phase<EpiGU<true>, pg8::StaticOrder, true, true>(ldsl, g, S, E);
            } else {
                EpiGU<false> E{hbuf, ss, nullptr};
                pg8::gemm_phase<EpiGU<false>, pg8::StaticOrder, true, true>(ldsl, g, S, E);
            }
            {
                int bxd = bx; asm volatile("" : "+s"(bxd));
                const int remD2 = ((M / 256) * (2 * FF / 256)) % G, firstD2 = remD2 ? remD2 : 0, nconvD2 = remD2 ? G - remD2 : G;
                if (bxd >= firstD2) { LAS float* scr = (LAS float*)ldsl;
                    for (int r = bxd - firstD2; r < CV_DN; r += nconvD2) convert_macro(p.in[I_WDOWN] + (size_t)l * FF * D, nullptr, FF, D, wdn_t, (r / 4) * 64, (r % 4) * 256, 0, scr, tid); }
            }
        } else if ((k == 5 && (PHMASK & 32)) || (k == 7 && (PHMASK & 128))) {
            const pg8::Gemm g = (k == 5) ? pg8::Gemm{mix, wout_t, M, D, D} : pg8::Gemm{hbuf, wdn_t, M, D, FF};
            pg8::StaticOrder S; S.init(M, D, G, bx);
            if (k == 5 && l == 0) { EpiRes<true, false> E{p.in[I_X], xg, nullptr, ss}; pg8::gemm_phase<EpiRes<true, false>, pg8::StaticOrder, true, true>(ldsl, g, S, E); }
            else if (k == 7 && l + 1 == DEPTH) { EpiRes<false, true> E{nullptr, xg, p.out, ss}; pg8::gemm_phase<EpiRes<false, true>, pg8::StaticOrder, true, true>(ldsl, g, S, E); }
            else { EpiRes<false, false> E{nullptr, xg, nullptr, ss}; pg8::gemm_phase<EpiRes<false, false>, pg8::StaticOrder, true, true>(ldsl, g, S, E); }
        }
    }
}

extern "C" void kernel_launch(void* const* d_in, const int* in_sizes, int n_in, void* d_out, int out_size, void* d_ws, size_t ws_size, hipStream_t stream) {
    static int grid = 0;
    if (grid == 0) {
        if (n_in != 17 || in_sizes[0] != M * D || out_size != M * D || ws_size < WS_END) { fprintf(stderr, "kernel_launch: unexpected shapes (n_in %d, in0 %d, out %d, ws %zu); nothing launched\n", n_in, n_in > 0 ? in_sizes[0] : -1, out_size, ws_size); grid = -1; return; }
        int dev = 0, cus = 0, per_cu = 0;
        hipGetDevice(&dev); hipDeviceGetAttribute(&cus, hipDeviceAttributeMultiprocessorCount, dev);
        if (hipFuncSetAttribute((const void*)fwd_megakernel, hipFuncAttributeMaxDynamicSharedMemorySize, LDS_BYTES) != hipSuccess) { fprintf(stderr, "kernel_launch: hipFuncSetAttribute failed\n"); grid = -1; return; }
        if (hipOccupancyMaxActiveBlocksPerMultiprocessor(&per_cu, (const void*)fwd_megakernel, NTHR, LDS_BYTES) != hipSuccess || per_cu < 1) { fprintf(stderr, "kernel_launch: occupancy query says %d\n", per_cu); per_cu = 1; }
        (void)hipGetLastError();
        grid = cus * per_cu;
    }
    if (grid < 0) return;
    if (hipMemsetAsync((char*)d_ws + WS_BAR, 0, BAR_BYTES, stream) != hipSuccess) { fprintf(stderr, "kernel_launch: memset of the barrier words failed\n"); return; }
    Params p{};
    for (int i = 0; i < 17; ++i) p.in[i] = (const float*)d_in[i];
    p.out = (float*)d_out; p.ws = (unsigned char*)d_ws;
#if MK_PER_PHASE_LAUNCHES
    for (int ph = 0; ph < N_PHASES; ++ph) { p.ph_lo = ph; p.ph_hi = ph + 1; hipLaunchKernelGGL(fwd_megakernel, dim3(grid), dim3(NTHR), LDS_BYTES, stream, p); }
#else
    p.ph_lo = 0; p.ph_hi = N_PHASES;
    void* args[] = {&p};
    hipError_t e = hipLaunchCooperativeKernel((const void*)fwd_megakernel, dim3(grid), dim3(NTHR), args, LDS_BYTES, stream);
    if (e != hipSuccess) fprintf(stderr, "cooperative launch failed: %s (grid %d)\n", hipGetErrorString(e), grid);
#endif
}
```

```cpp
#include <hip/hip_runtime.h>
#include <hip/hip_cooperative_groups.h>
#include <hip/hip_bf16.h>
#include <cstdio>
#include <cstdint>
#include <cmath>
namespace cg = cooperative_groups;
#ifndef MK_PER_PHASE_LAUNCHES
#define MK_PER_PHASE_LAUNCHES 0
#endif
namespace pg8 {
#define PG8_LAS __attribute__((address_space(3)))
typedef unsigned short bf16_t;
typedef short bf16x8 __attribute__((ext_vector_type(8)));
typedef float f32x4 __attribute__((ext_vector_type(4)));
typedef unsigned u32x4 __attribute__((ext_vector_type(4)));
constexpr int BM = 256, BK = 64, HALF = 128, HTB = HALF * BK * 2  , STAGE_BYTES = 8 * HTB, NXCD = 8, WGM = 8;

__host__ __device__ __forceinline__ int lds_byte(int r, int c) { const int st = (r >> 4) * 2 + (c >> 5), rr = r & 15, cc = c & 31, ob = rr * 64 + cc * 2; return st * 1024 + (ob ^ (((ob >> 9) & 1) << 5)); }
__host__ __device__ __forceinline__ void stage_rc(int b, int& R, int& C) { const int st = b / 1024, sb = b % 1024, swz = sb ^ (((sb >> 9) & 1) << 5); R = (st >> 1) * 16 + swz / 64; C = (st & 1) * 32 + (swz % 64) / 2; }
__host__ __device__ __forceinline__ int perm32(int rho) { const int n = rho >> 4, i = rho & 15; return 8 * (i >> 2) + 4 * n + (i & 3); }

struct Unit { int pm, pn; };
struct Gemm { const bf16_t* A; const bf16_t* Bt; int M, N, K; };

struct StaticOrder {
    int nM, nN, nwg, G, c;
    __host__ __device__ void init(int M, int N, int G_, int c_) { nM = M / BM; nN = N / BM; nwg = nM * nN; G = G_; c = c_; }
    __host__ __device__ bool next(int i, Unit& u) const {
        const long L = (long)i * G + c; if (L >= nwg) return false;
        int wgid = (int)L; { const int q = nwg / NXCD, r = nwg % NXCD, xcd = wgid % NXCD, off = wgid / NXCD; wgid = (xcd < r ? xcd * (q + 1) : r * (q + 1) + (xcd - r) * q) + off; }
        const int nig = WGM * nN, gid = wgid / nig, fm = gid * WGM, gsz = (nM - fm) < WGM ? (nM - fm) : WGM;
        u.pm = fm + ((wgid % nig) % gsz); u.pn = (wgid % nig) / gsz; return true;
    }
    __device__ __forceinline__ void a_ready(const Unit&) const {}
    __device__ __forceinline__ void done(const Unit&) const {}
};

__device__ __forceinline__ unsigned cvt_pk_bf16(float lo, float hi) { unsigned r; asm volatile("v_cvt_pk_bf16_f32 %0, %1, %2" : "=v"(r) : "v"(lo), "v"(hi)); return r; }

template <class Epi, class Sched, bool ALIGN_EPI = false, bool SP2 = false>
__device__ __forceinline__ void gemm_phase(PG8_LAS unsigned char* lds, const Gemm g, const Sched& S, const Epi& E) {
    int tid_ = threadIdx.x; asm volatile("" : "+v"(tid_));
    const int tid = tid_, wid = __builtin_amdgcn_readfirstlane(tid >> 6), lane = tid & 63, wr = wid >> 2, wc = wid & 3, fr = lane & 15, fq = lane >> 4;
    const int K = g.K, nt = K / BK;
    unsigned voffA[2], voffB[2];
#pragma unroll
    for (int i = 0; i < 2; ++i) { int R, C; stage_rc(tid * 16 + i * 8192, R, C); const int Rb = Epi::PERM ? ((R & ~31) + perm32(R & 31)) : R;
        voffA[i] = (unsigned)(R * K + C) * 2u; voffB[i] = (unsigned)(Rb * K + C) * 2u; }
    const size_t kstep = (size_t)(BK * 2);
    const size_t hstep = (size_t)HALF * K * 2;
    const size_t tstep = 2 * hstep;
    const unsigned ldsw = (unsigned)wid * 1024u;
    const int aoff = lds_byte(wr * 64 + fr, fq * 8), boff = lds_byte(wc * 32 + fr, fq * 8);
#define PG8_SA(b, h) (((b) * 2 + (h)) * HTB)
#define PG8_SB(b, h) ((4 + (b) * 2 + (h)) * HTB)
#define PG8_STAGE(bufoff, gbase, voff) do { _Pragma("unroll") for (int _i = 0; _i < 2; ++_i) \
        __builtin_amdgcn_global_load_lds((const unsigned*)((const char*)(gbase) + (voff)[_i]), (PG8_LAS unsigned*)(lds + (bufoff) + ldsw + _i * 8192), 16, 0, 0); } while (0)
#define PG8_LDA(dst, b, h) do { _Pragma("unroll") for (int m = 0; m < 4; ++m) _Pragma("unroll") for (int k = 0; k < 2; ++k) dst[m][k] = *(const PG8_LAS bf16x8*)(lds + PG8_SA(b, h) + aoff + m * 2048 + k * 1024); } while (0)
#define PG8_LDB(dst, b, h) do { _Pragma("unroll") for (int n = 0; n < 2; ++n) _Pragma("unroll") for (int k = 0; k < 2; ++k) dst[n][k] = *(const PG8_LAS bf16x8*)(lds + PG8_SB(b, h) + boff + n * 2048 + k * 1024); } while (0)
#define PG8_MMA(ai, bj, At, Bt) do { __builtin_amdgcn_s_setprio(1); _Pragma("unroll") for (int m = 0; m < 4; ++m) _Pragma("unroll") for (int n = 0; n < 2; ++n) _Pragma("unroll") for (int k = 0; k < 2; ++k) \
        acc[ai][bj][m][n] = __builtin_amdgcn_mfma_f32_16x16x32_bf16(Bt[n][k], At[m][k], acc[ai][bj][m][n], 0, 0, 0); __builtin_amdgcn_s_setprio(0); } while (0)
#define PG8_WAIT_V(n) asm volatile("s_waitcnt vmcnt(" #n ")" ::: "memory")
#define PG8_WAIT_L(n) asm volatile("s_waitcnt lgkmcnt(" #n ")" ::: "memory")
#define PG8_BAR __builtin_amdgcn_s_barrier()
#define PG8_SCHED __builtin_amdgcn_sched_barrier(0)
    Unit cur, nxt; int ui = 0;
    if (!S.next(0, cur)) return;
    f32x4 acc[2][2][4][2];
#pragma unroll
    for (int a = 0; a < 2; ++a)
#pragma unroll
        for (int b = 0; b < 2; ++b)
#pragma unroll
            for (int m = 0; m < 4; ++m)
#pragma unroll
                for (int n = 0; n < 2; ++n) acc[a][b][m][n] = (f32x4){0.f, 0.f, 0.f, 0.f};
    bf16x8 At[4][2], B0[2][2], B1[2][2];
    const char* cA = (const char*)g.A + (size_t)cur.pm * tstep; const char* cB = (const char*)g.Bt + (size_t)cur.pn * tstep;
    S.a_ready(cur);
    if constexpr (SP2) {
        PG8_STAGE(PG8_SB(0, 0), cB, voffB); PG8_STAGE(PG8_SB(0, 1), cB + hstep, voffB); PG8_STAGE(PG8_SA(0, 0), cA, voffA); PG8_STAGE(PG8_SA(0, 1), cA + hstep, voffA);
        if (wr == 1) PG8_BAR;
        PG8_WAIT_V(2); PG8_BAR;
        PG8_STAGE(PG8_SB(1, 0), cB + kstep, voffB); PG8_STAGE(PG8_SA(1, 0), cA + kstep, voffA); PG8_STAGE(PG8_SB(1, 1), cB + hstep + kstep, voffB);
        PG8_WAIT_V(6); PG8_BAR;
    } else {
        PG8_STAGE(PG8_SB(0, 0), cB, voffB); PG8_STAGE(PG8_SA(0, 0), cA, voffA); PG8_STAGE(PG8_SB(0, 1), cB + hstep, voffB); PG8_STAGE(PG8_SA(0, 1), cA + hstep, voffA);
        if (wr == 1) PG8_BAR;
        PG8_WAIT_V(4); PG8_BAR;
        PG8_STAGE(PG8_SB(1, 0), cB + kstep, voffB); PG8_STAGE(PG8_SA(1, 0), cA + kstep, voffA); PG8_STAGE(PG8_SB(1, 1), cB + hstep + kstep, voffB);
        PG8_WAIT_V(6); PG8_BAR;
    }
    for (;;) {
        const bool has_next = S.next(ui + 1, nxt);
        const char* nA = has_next ? (const char*)g.A + (size_t)nxt.pm * tstep : cA; const char* nB = has_next ? (const char*)g.Bt + (size_t)nxt.pn * tstep : cB;
        for (int t = 0; t < nt; t += 2) {
            const bool last = (t == nt - 2);
            const char* a1 = cA + (size_t)(t + 1) * kstep;
            const char* a2 = last ? nA : cA + (size_t)(t + 2) * kstep; const char* b2 = last ? nB : cB + (size_t)(t + 2) * kstep;
            const char* a3 = a2 + kstep; const char* b3 = b2 + kstep;
            if (last && has_next) S.a_ready(nxt);
            if constexpr (SP2) {
            PG8_LDB(B0, 0, 0); PG8_LDB(B1, 0, 1); PG8_SCHED; PG8_LDA(At, 0, 0); PG8_STAGE(PG8_SA(1, 1), a1 + hstep, voffA);
            PG8_WAIT_V(8); PG8_WAIT_L(0); PG8_BAR; PG8_MMA(0, 0, At, B0); PG8_MMA(0, 1, At, B1); PG8_BAR; PG8_SCHED;
            PG8_LDA(At, 0, 1); PG8_STAGE(PG8_SB(0, 0), b2, voffB); PG8_STAGE(PG8_SB(0, 1), b2 + hstep, voffB); PG8_STAGE(PG8_SA(0, 0), a2, voffA);
            PG8_WAIT_V(8); PG8_WAIT_L(0); PG8_BAR; PG8_MMA(1, 0, At, B0); PG8_MMA(1, 1, At, B1); PG8_BAR; PG8_SCHED;
            PG8_LDB(B0, 1, 0); PG8_LDB(B1, 1, 1); PG8_SCHED; PG8_LDA(At, 1, 0); PG8_STAGE(PG8_SA(0, 1), a2 + hstep, voffA);
            PG8_WAIT_V(8); PG8_WAIT_L(0); PG8_BAR; PG8_MMA(0, 0, At, B0); PG8_MMA(0, 1, At, B1); PG8_BAR; PG8_SCHED;
            PG8_LDA(At, 1, 1); PG8_STAGE(PG8_SB(1, 0), b3, voffB); PG8_STAGE(PG8_SB(1, 1), b3 + hstep, voffB); PG8_STAGE(PG8_SA(1, 0), a3, voffA);
            PG8_WAIT_V(8); PG8_WAIT_L(0); PG8_BAR; PG8_MMA(1, 0, At, B0); PG8_MMA(1, 1, At, B1); PG8_BAR; PG8_SCHED;
            } else {
            PG8_LDB(B0, 0, 0); PG8_SCHED; PG8_LDA(At, 0, 0); PG8_STAGE(PG8_SA(1, 1), a1 + hstep, voffA);
            PG8_WAIT_L(8); PG8_BAR; PG8_WAIT_L(0); PG8_MMA(0, 0, At, B0); PG8_BAR; PG8_SCHED;
            PG8_LDB(B1, 0, 1); PG8_STAGE(PG8_SB(0, 0), b2, voffB);
            PG8_BAR; PG8_WAIT_L(0); PG8_MMA(0, 1, At, B1); PG8_BAR;
            PG8_LDA(At, 0, 1); PG8_STAGE(PG8_SA(0, 0), a2, voffA);
            PG8_BAR; PG8_WAIT_L(0); PG8_MMA(1, 0, At, B0); PG8_BAR; PG8_SCHED;
            PG8_STAGE(PG8_SB(0, 1), b2 + hstep, voffB);
            PG8_WAIT_V(6); PG8_BAR; PG8_MMA(1, 1, At, B1); PG8_BAR;
            PG8_LDB(B0, 1, 0); PG8_SCHED; PG8_LDA(At, 1, 0); PG8_STAGE(PG8_SA(0, 1), a2 + hstep, voffA);
            PG8_WAIT_L(8); PG8_BAR; PG8_WAIT_L(0); PG8_MMA(0, 0, At, B0); PG8_BAR; PG8_SCHED;
            PG8_LDB(B1, 1, 1); PG8_STAGE(PG8_SB(1, 0), b3, voffB);
            PG8_BAR; PG8_WAIT_L(0); PG8_MMA(0, 1, At, B1); PG8_BAR;
            PG8_LDA(At, 1, 1); PG8_STAGE(PG8_SA(1, 0), a3, voffA);
            PG8_BAR; PG8_WAIT_L(0); PG8_MMA(1, 0, At, B0); PG8_BAR; PG8_SCHED;
            PG8_STAGE(PG8_SB(1, 1), b3 + hstep, voffB);
            PG8_WAIT_V(6); PG8_BAR; PG8_MMA(1, 1, At, B1); PG8_BAR;
            }
        }
        if constexpr (ALIGN_EPI) { if (wr == 0) PG8_BAR; }
        if constexpr (!Epi::AFTER_DRAIN) { E(acc, cur, wr, wc, fr, fq); S.done(cur); }
        if (!has_next) break;
#pragma unroll
        for (int a = 0; a < 2; ++a)
#pragma unroll
            for (int b = 0; b < 2; ++b)
#pragma unroll
                for (int m = 0; m < 4; ++m)
#pragma unroll
                    for (int n = 0; n < 2; ++n) acc[a][b][m][n] = (f32x4){0.f, 0.f, 0.f, 0.f};
        cur = nxt; cA = nA; cB = nB; ++ui;
        if constexpr (ALIGN_EPI) { if (wr == 1) PG8_BAR; }
    }
    PG8_WAIT_V(0);
    if constexpr (!ALIGN_EPI) { if (wr == 0) PG8_BAR; }
    PG8_BAR;
    if constexpr (Epi::AFTER_DRAIN) { E.fused(acc, cur, wr, wc, fr, fq, lds, wid, lane); S.done(cur); }
#undef PG8_SA
#undef PG8_SB
#undef PG8_STAGE
#undef PG8_LDA
#undef PG8_LDB
#undef PG8_MMA
#undef PG8_WAIT_V
#undef PG8_WAIT_L
#undef PG8_BAR
#undef PG8_SCHED
}
}
#ifndef PG8_SP2
#define PG8_SP2 true
#endif
namespace attn_body {
using bf16=__hip_bfloat16;
using bf16x8=__attribute__((ext_vector_type(8)))short;
using s16x4=__attribute__((ext_vector_type(4)))short;
using f32x16=__attribute__((ext_vector_type(16)))float;
using u32x4=__attribute__((ext_vector_type(4)))unsigned;
constexpr int BATCH=4,SEQ=4096,D=64,PQ=3584,PO=1024;
constexpr int NW=8,QBLK=32,QB=QBLK*NW,KVBLK=64,NQB=SEQ/QB;
constexpr int ATTN_UNIT_ROWS=QB;
__device__ __forceinline__ int crow(int r,int hi){return (r&3)+8*(r>>2)+4*hi;}
#define SBAR() __builtin_amdgcn_sched_barrier(0)
__device__ __forceinline__ void cmask(f32x16&p0,f32x16&p1,int jb,int wid){
  const float NEG=-INFINITY;
  if(jb>(wid>>1)){
    #pragma unroll
    for(int r=0;r<16;++r){p0[r]=NEG;p1[r]=NEG;}}
}

constexpr int NSLOT=3, SLOTB=8192;
constexpr int LDS_K=0, LDS_V=NSLOT*SLOTB, LDS_WS=3*NSLOT*SLOTB, LDS_OST=LDS_WS+NW*64*4, LDS_BYTES=LDS_OST+NW*4096;
constexpr float C2=0.125f*1.4426950408889634f;
__device__ __forceinline__ void glds16(const void*gsrc,unsigned lds_dst){unsigned keep;
  asm volatile("s_mov_b32 %0, m0\n\ts_mov_b32 m0, %2\n\ts_nop 0\n\tglobal_load_lds_dwordx4 %1, off\n\ts_mov_b32 m0, %0":"=&s"(keep):"v"(gsrc),"s"(lds_dst):"memory");}
__device__ __forceinline__ float max3f(float a,float b,float c){float r;asm("v_max3_f32 %0, %1, %2, %3":"=v"(r):"v"(a),"v"(b),"v"(c));return r;}
__device__ __forceinline__ float max2f(float a,float b){float r;asm("v_max_f32_e32 %0, %1, %2":"=v"(r):"v"(a),"v"(b));return r;}
__device__ __forceinline__ float fadd_s(float a,float b){float r;asm("v_add_f32_e32 %0, %1, %2":"=v"(r):"v"(a),"v"(b));return r;}
__device__ __forceinline__ float fsub_s(float a,float b){float r;asm("v_sub_f32_e32 %0, %1, %2":"=v"(r):"v"(a),"v"(b));return r;}
typedef float f32x2_t __attribute__((ext_vector_type(2))); typedef __bf16 bf16x2_t __attribute__((ext_vector_type(2)));
__device__ __forceinline__ unsigned cvtpk_s(float lo,float hi){f32x2_t v={lo,hi};bf16x2_t b=__builtin_convertvector(v,bf16x2_t);return __builtin_bit_cast(unsigned,b);}
#define WAIT_BAR(N) asm volatile("s_waitcnt vmcnt(" #N ") lgkmcnt(0)\n\ts_barrier":::"memory")

__device__ __forceinline__ void qkt(f32x16&p0,f32x16&p1,const char*Kslot,const bf16x8*qr,const f32x16&negm,int r32,int hi){
  const char*kb=Kslot+hi*1024+r32*16;
  #pragma unroll
  for(int d0=0;d0<4;++d0){
    const bf16x8 b0=*reinterpret_cast<const bf16x8*>(kb+d0*2048);
    const bf16x8 b1=*reinterpret_cast<const bf16x8*>(kb+d0*2048+512);
    if(d0==0){p0=__builtin_amdgcn_mfma_f32_32x32x16_bf16(b0,qr[0],negm,0,0,0);p1=__builtin_amdgcn_mfma_f32_32x32x16_bf16(b1,qr[0],negm,0,0,0);}
    else{p0=__builtin_amdgcn_mfma_f32_32x32x16_bf16(b0,qr[d0],p0,0,0,0);p1=__builtin_amdgcn_mfma_f32_32x32x16_bf16(b1,qr[d0],p1,0,0,0);}}
}
typedef __attribute__((address_space(3))) const char* lds_cptr;
typedef short v4i16_t __attribute__((ext_vector_type(4)));
__device__ __forceinline__ void kload8(bf16x8*kf,lds_cptr kp){
  kf[0]=*(const __attribute__((address_space(3))) bf16x8*)(kp);      kf[1]=*(const __attribute__((address_space(3))) bf16x8*)(kp+512);
  kf[2]=*(const __attribute__((address_space(3))) bf16x8*)(kp+2048); kf[3]=*(const __attribute__((address_space(3))) bf16x8*)(kp+2560);
  kf[4]=*(const __attribute__((address_space(3))) bf16x8*)(kp+4096); kf[5]=*(const __attribute__((address_space(3))) bf16x8*)(kp+4608);
  kf[6]=*(const __attribute__((address_space(3))) bf16x8*)(kp+6144); kf[7]=*(const __attribute__((address_space(3))) bf16x8*)(kp+6656);
}
__device__ __forceinline__ void kload2(bf16x8*kf,lds_cptr kp,int j){ kf[2*j]=*(const __attribute__((address_space(3))) bf16x8*)(kp+j*2048); kf[2*j+1]=*(const __attribute__((address_space(3))) bf16x8*)(kp+j*2048+512); }
__device__ __forceinline__ s16x4 vtr(lds_cptr p){ return __builtin_bit_cast(s16x4,__builtin_amdgcn_ds_read_tr16_b64_v4i16((__attribute__((address_space(3))) v4i16_t*)p)); }
__device__ __forceinline__ float rowmax(const f32x16&p0,const f32x16&p1){
  float a=max3f(p0[0],p0[1],p1[0]),b=max3f(p0[2],p0[3],p1[1]);a=max3f(a,p1[2],p1[3]);
  #pragma unroll
  for(int r=4;r<16;r+=4){a=max3f(a,p0[r],p0[r+1]);b=max3f(b,p0[r+2],p0[r+3]);a=max3f(a,p1[r],p1[r+1]);b=max3f(b,p1[r+2],p1[r+3]);}
  const float m=max2f(a,b);
  auto rr=__builtin_amdgcn_permlane32_swap(__float_as_uint(m),__float_as_uint(m),false,false);
  return max2f(__uint_as_float(rr[0]),__uint_as_float(rr[1]));
}
__device__ __forceinline__ void pv(f32x16*o,int vb,bf16x8 pa0,bf16x8 pa1,bf16x8 pa2,bf16x8 pa3){
  #pragma unroll
  for(int d0=0;d0<2;++d0){s16x4 lo[4],hi[4];
    #pragma unroll
    for(int ks=0;ks<4;++ks){
      asm volatile("ds_read_b64_tr_b16 %0,%1 offset:%c2":"=&v"(lo[ks]):"v"(vb),"i"(d0*4096+ks*1024):"memory");
      asm volatile("ds_read_b64_tr_b16 %0,%1 offset:%c2":"=&v"(hi[ks]):"v"(vb),"i"(d0*4096+ks*1024+512):"memory");}
    asm volatile("s_waitcnt lgkmcnt(0)":::"memory");SBAR();
    #define PK(k) (bf16x8){lo[k][0],lo[k][1],lo[k][2],lo[k][3],hi[k][0],hi[k][1],hi[k][2],hi[k][3]}
    o[d0]=__builtin_amdgcn_mfma_f32_32x32x16_bf16(pa0,PK(0),o[d0],0,0,0);
    o[d0]=__builtin_amdgcn_mfma_f32_32x32x16_bf16(pa1,PK(1),o[d0],0,0,0);
    o[d0]=__builtin_amdgcn_mfma_f32_32x32x16_bf16(pa2,PK(2),o[d0],0,0,0);
    o[d0]=__builtin_amdgcn_mfma_f32_32x32x16_bf16(pa3,PK(3),o[d0],0,0,0);
    #undef PK
  }
}

#ifndef ATTN_STORE16
#define ATTN_STORE16(p,v) (*(u32x4*)(p)=(v))
#endif
template<int THRL> __device__ __forceinline__ void attn_unit(int b,int qcol,int kcol,int vcol,int ocol,int qb,const bf16*__restrict__ P,bf16*O,char*shm){
  int tid_=threadIdx.x; asm volatile("":"+v"(tid_)); const int tid=tid_,lane=tid&63,r32=lane&31,hi=lane>>5; const int wid=__builtin_amdgcn_readfirstlane(tid>>6);
  const long rowbase=(long)b*SEQ; const int q0=qb*QB;
  const bf16*Qw=P+(rowbase+q0+wid*QBLK)*PQ+qcol;
  const bf16*Kh=P+rowbase*PQ+kcol,*Vh=P+rowbase*PQ+vcol;
  const unsigned lds0=(unsigned)(uintptr_t)shm;
  float*wsf=(float*)(shm+LDS_WS)+wid*64;
  const bf16*ksrc=Kh+(long)lane*PQ+wid*8;
  const bf16*vsrc=Vh+(long)(16*(wid&3)+(lane>>2))*PQ+(wid>>2)*32+(lane&3)*8;
  const unsigned kdst=lds0+LDS_K+wid*1024, vdst=lds0+LDS_V+wid*1024;
  #define DMA_K(t,slot) glds16(ksrc+(long)(t)*KVBLK*PQ,(unsigned)__builtin_amdgcn_readfirstlane(kdst+(slot)))
  #define DMA_V(t,slot) do{ glds16(vsrc+(long)(t)*KVBLK*PQ,(unsigned)__builtin_amdgcn_readfirstlane(vdst+2*(slot))); glds16(vsrc+(long)(t)*KVBLK*PQ+64,(unsigned)__builtin_amdgcn_readfirstlane(vdst+2*(slot)+8192)); }while(0)
  const int vb0=(int)(lds0+LDS_V)+((lane>>4)&1)*32+(lane&3)*8+(4*hi+((lane&15)>>2))*64;
  const char*Kbase=shm+LDS_K; bf16x8 kf[8];
  const lds_cptr shm3=(lds_cptr)shm; const lds_cptr kp0=shm3+LDS_K+hi*1024+r32*16; const lds_cptr vp0=shm3+LDS_V+((lane>>4)&1)*32+(lane&3)*8+(4*hi+((lane&15)>>2))*64;
  const int NT=(q0+QB)/KVBLK;
  DMA_K(0,0);DMA_V(0,0);DMA_K(1,SLOTB);
  bf16x8 qr[4];
  #pragma unroll
  for(int d0=0;d0<4;++d0)qr[d0]=*reinterpret_cast<const bf16x8*>(&Qw[(long)r32*PQ+d0*16+hi*8]);
  float mhat=0.f,l_reg=0.f;f32x16 o[4];o[0]=f32x16{};o[1]=f32x16{};o[2]=f32x16{};o[3]=f32x16{};f32x16 negm=f32x16{};asm volatile("":"+v"(negm));
  const int qrel=wid*QBLK+r32;
  #define CMASK(P0,P1,t) do{int jb_=(t)-(NT-4); if(jb_>=0)cmask(P0,P1,jb_,wid);}while(0)
  bool resc=false;
  #define START(P0,P1) do{ const float rm=rowmax(P0,P1); resc=false; \
    { const float dl=rm; mhat=fadd_s(mhat,dl); \
      _Pragma("unroll") for(int r=0;r<16;++r){P0[r]=fsub_s(P0[r],dl);P1[r]=fsub_s(P1[r],dl);} \
      _Pragma("unroll") for(int r=0;r<16;++r)negm[r]=-mhat; asm volatile("":"+v"(negm)); } \
    _Pragma("unroll") for(int r=0;r<16;++r)P0[r]=__builtin_amdgcn_exp2f(P0[r]); }while(0)
  #define RESC() do{ if(resc){ asm volatile("s_waitcnt lgkmcnt(0)":::"memory"); \
      _Pragma("unroll") for(int d_=0;d_<4;++d_) _Pragma("unroll") for(int r=0;r<16;++r)o[d_][r]*=wsf[crow(r,hi)]; } }while(0)
  f32x16 pA0,pA1,pB0,pB1;
  int sl_prev=0,sl_cur=0,sl_next=SLOTB;
  #define ROT() do{sl_prev=sl_cur;sl_cur=sl_next;sl_next=(sl_next==(NSLOT-1)*SLOTB)?0:sl_next+SLOTB;}while(0)
  DMA_K(2,2*SLOTB);
  WAIT_BAR(3);
  qkt(pA0,pA1,Kbase,qr,negm,r32,hi);asm volatile("s_nop 15\n\ts_nop 7":"+v"(pA0),"+v"(pA1));CMASK(pA0,pA1,0);
  START(pA0,pA1);
  _Pragma("unroll") for(int r=0;r<16;++r)pA1[r]=__builtin_amdgcn_exp2f(pA1[r]);
  WAIT_BAR(0);
  DMA_K(3,0);DMA_V(1,SLOTB);
  ROT();
  kload8(kf,kp0+sl_cur);
  WAIT_BAR(3);
  s16x4 vlo[8],vhi[8]; u32x4 pw0,pw1,pw2,pw3;
  #define PKW(P,B) cvtpk_s(P[B],P[B+1])
  #define PAF(k) __builtin_bit_cast(bf16x8,pw##k)
  #define VFR(i) (bf16x8){vlo[i][0],vlo[i][1],vlo[i][2],vlo[i][3],vhi[i][0],vhi[i][1],vhi[i][2],vhi[i][3]}
  #define PIN(x) asm volatile("":"+v"(x))
  #define MX3(a,b,c) __builtin_fmaxf(__builtin_fmaxf((a),(b)),(c))
  #define GAPA(MF,A0,A1,A2,A3,W0,W1,PW) do{ MF; sacc+=A0; sacc+=A1; sacc+=A2; sacc+=A3; PIN(sacc); W0; W1; PIN(PW); SBAR(); }while(0)
  #define EX(v) __builtin_amdgcn_exp2f(v)
  #define GAPB(MF,X,B) do{ MF; X[B]=EX(X[B]); X[B+1]=EX(X[B+1]); PIN(X); SBAR(); }while(0)
  #define GAPB2(MF,X,B,i) do{ MF; VRD2(i); X[B]=EX(X[B]); X[B+1]=EX(X[B+1]); PIN(X); SBAR(); }while(0)
  #define VRD(i) do{ vlo[i]=vtr(vp_+(((i)>>2)*4096+((i)&3)*1024)); vhi[i]=vtr(vp_+(((i)>>2)*4096+((i)&3)*1024+512)); }while(0)
  #define VRD2(i) do{ vlo[i]=vtr(vp_+(8192+((i)>>2)*4096+((i)&3)*1024)); vhi[i]=vtr(vp_+(8192+((i)>>2)*4096+((i)&3)*1024+512)); }while(0)
  #define KRD(G,j) do{ if(G){ kload2(kf,kp0+sl_next,j); SBAR(); } }while(0)
  #define STEP(C0,C1,P0,P1,t,GK,GV,GL) do{ SBAR(); \
    const lds_cptr vp_=vp0+2*sl_prev; \
    VRD(0); SBAR(); float sacc=(P0[0]+P0[1]); \
    GAPA(C0=__builtin_amdgcn_mfma_f32_32x32x16_bf16(kf[0],qr[0],negm,0,0,0), P0[2],P0[3],P0[4],P0[5],     pw0[0]=PKW(P0,0), pw0[1]=PKW(P0,2), pw0); \
    VRD(4); SBAR(); GAPA(C1=__builtin_amdgcn_mfma_f32_32x32x16_bf16(kf[1],qr[0],negm,0,0,0), P0[6],P0[7],P0[8],P0[9],     pw0[2]=PKW(P0,4), pw0[3]=PKW(P0,6), pw0); \
    VRD(1); SBAR(); GAPA(C0=__builtin_amdgcn_mfma_f32_32x32x16_bf16(kf[2],qr[1],C0,0,0,0),   P0[10],P0[11],P0[12],P0[13], pw1[0]=PKW(P0,8), pw1[1]=PKW(P0,10), pw1); \
    VRD(5); SBAR(); GAPA(C1=__builtin_amdgcn_mfma_f32_32x32x16_bf16(kf[3],qr[1],C1,0,0,0),   P0[14],P0[15],P1[0],P1[1],   pw1[2]=PKW(P0,12),pw1[3]=PKW(P0,14), pw1); \
    VRD(2); SBAR(); GAPA(C0=__builtin_amdgcn_mfma_f32_32x32x16_bf16(kf[4],qr[2],C0,0,0,0),   P1[2],P1[3],P1[4],P1[5],     pw2[0]=PKW(P1,0), pw2[1]=PKW(P1,2), pw2); \
    VRD(6); SBAR(); GAPA(C1=__builtin_amdgcn_mfma_f32_32x32x16_bf16(kf[5],qr[2],C1,0,0,0),   P1[6],P1[7],P1[8],P1[9],     pw2[2]=PKW(P1,4), pw2[3]=PKW(P1,6), pw2); \
    VRD(3); SBAR(); GAPA(C0=__builtin_amdgcn_mfma_f32_32x32x16_bf16(kf[6],qr[3],C0,0,0,0),   P1[10],P1[11],P1[12],P1[13], pw3[0]=PKW(P1,8), pw3[1]=PKW(P1,10), pw3); \
    VRD(7); SBAR(); GAPA(C1=__builtin_amdgcn_mfma_f32_32x32x16_bf16(kf[7],qr[3],C1,0,0,0),   P1[14],P1[15],0.f,0.f,       pw3[2]=PKW(P1,12),pw3[3]=PKW(P1,14), pw3); \
    l_reg+=sacc; \
    if(GK){DMA_K((t)+3,sl_cur);} if(GV){DMA_V((t)+1,sl_next);} \
    CMASK(C0,C1,t); \
    { float a=MX3(C0[0],C0[1],C1[0]),b=MX3(C0[2],C0[3],C1[1]); a=MX3(a,C1[2],C1[3]); \
      _Pragma("unroll") for(int r=4;r<16;r+=4){a=MX3(a,C0[r],C0[r+1]);b=MX3(b,C0[r+2],C0[r+3]);a=MX3(a,C1[r],C1[r+1]);b=MX3(b,C1[r+2],C1[r+3]);} \
      float rm=__builtin_fmaxf(a,b); { auto rr=__builtin_amdgcn_permlane32_swap(__float_as_uint(rm),__float_as_uint(rm),false,false); rm=__builtin_fmaxf(__uint_as_float(rr[0]),__uint_as_float(rr[1])); } \
      resc=false; \
      if(__builtin_expect(__any(rm>(float)THRL),0)){ const float dl=__builtin_fmaxf(rm,0.f); mhat+=dl; \
        _Pragma("unroll") for(int r=0;r<16;++r){C0[r]-=dl;C1[r]-=dl;} \
        _Pragma("unroll") for(int r=0;r<16;++r)negm[r]=-mhat; asm volatile("":"+v"(negm)); \
        const float f=__builtin_amdgcn_exp2f(-dl); l_reg*=f; if(hi==0)wsf[r32]=f; resc=true; } } \
    SBAR(); \
    GAPB(o[0]=__builtin_amdgcn_mfma_f32_32x32x16_bf16(PAF(0),VFR(0),o[0],0,0,0), C0,0); \
    GAPB(o[1]=__builtin_amdgcn_mfma_f32_32x32x16_bf16(PAF(0),VFR(4),o[1],0,0,0), C0,2); \
    KRD(GL,0); GAPB(o[0]=__builtin_amdgcn_mfma_f32_32x32x16_bf16(PAF(1),VFR(1),o[0],0,0,0), C0,4); \
    KRD(GL,1); GAPB(o[1]=__builtin_amdgcn_mfma_f32_32x32x16_bf16(PAF(1),VFR(5),o[1],0,0,0), C0,6); \
    KRD(GL,2); GAPB2(o[0]=__builtin_amdgcn_mfma_f32_32x32x16_bf16(PAF(2),VFR(2),o[0],0,0,0), C0,8,0); \
    KRD(GL,3); GAPB2(o[1]=__builtin_amdgcn_mfma_f32_32x32x16_bf16(PAF(2),VFR(6),o[1],0,0,0), C0,10,4); \
    GAPB2(o[0]=__builtin_amdgcn_mfma_f32_32x32x16_bf16(PAF(3),VFR(3),o[0],0,0,0), C0,12,1); \
    GAPB2(o[1]=__builtin_amdgcn_mfma_f32_32x32x16_bf16(PAF(3),VFR(7),o[1],0,0,0), C0,14,5); \
      \
      \
    VRD2(2); VRD2(6); VRD2(3); VRD2(7); SBAR(); \
    GAPB(o[2]=__builtin_amdgcn_mfma_f32_32x32x16_bf16(PAF(0),VFR(0),o[2],0,0,0), C1,0); \
    GAPB(o[3]=__builtin_amdgcn_mfma_f32_32x32x16_bf16(PAF(0),VFR(4),o[3],0,0,0), C1,2); \
    GAPB(o[2]=__builtin_amdgcn_mfma_f32_32x32x16_bf16(PAF(1),VFR(1),o[2],0,0,0), C1,4); \
    GAPB(o[3]=__builtin_amdgcn_mfma_f32_32x32x16_bf16(PAF(1),VFR(5),o[3],0,0,0), C1,6); \
    GAPB(o[2]=__builtin_amdgcn_mfma_f32_32x32x16_bf16(PAF(2),VFR(2),o[2],0,0,0), C1,8); \
    GAPB(o[3]=__builtin_amdgcn_mfma_f32_32x32x16_bf16(PAF(2),VFR(6),o[3],0,0,0), C1,10); \
    GAPB(o[2]=__builtin_amdgcn_mfma_f32_32x32x16_bf16(PAF(3),VFR(3),o[2],0,0,0), C1,12); \
    GAPB(o[3]=__builtin_amdgcn_mfma_f32_32x32x16_bf16(PAF(3),VFR(7),o[3],0,0,0), C1,14); \
    }while(0)
  int t=1;
  #undef CMASK
  #define CMASK(P0,P1,t) do{}while(0)
  for(;t+5<NT;t+=2){
    STEP(pB0,pB1,pA0,pA1,t,true,true,true);     WAIT_BAR(3); RESC(); ROT();
    STEP(pA0,pA1,pB0,pB1,t+1,true,true,true);   WAIT_BAR(3); RESC(); ROT();
  }
  #undef CMASK
  #define CMASK(P0,P1,t) do{int jb_=(t)-(NT-4); if(jb_>=0)cmask(P0,P1,jb_,wid);}while(0)
  #define ENDW(tt) do{ if((tt)+3<NT){WAIT_BAR(3);} else if((tt)+2<NT){WAIT_BAR(2);} else {WAIT_BAR(0);} }while(0)
  for(;t+1<NT;t+=2){
    STEP(pB0,pB1,pA0,pA1,t,(t+3<NT),(t+1<NT),(t+1<NT));       ENDW(t);   RESC(); ROT();
    STEP(pA0,pA1,pB0,pB1,t+1,(t+4<NT),(t+2<NT),(t+2<NT));     ENDW(t+1); RESC(); ROT();
  }
  STEP(pB0,pB1,pA0,pA1,NT-1,false,false,false); RESC();
  { float sacc=pB0[0]+pB0[1]; _Pragma("unroll") for(int r=2;r<16;++r)sacc+=pB0[r]; _Pragma("unroll") for(int r=0;r<16;++r)sacc+=pB1[r]; l_reg+=sacc;
    pw0=(u32x4){PKW(pB0,0),PKW(pB0,2),PKW(pB0,4),PKW(pB0,6)};pw1=(u32x4){PKW(pB0,8),PKW(pB0,10),PKW(pB0,12),PKW(pB0,14)};pw2=(u32x4){PKW(pB1,0),PKW(pB1,2),PKW(pB1,4),PKW(pB1,6)};pw3=(u32x4){PKW(pB1,8),PKW(pB1,10),PKW(pB1,12),PKW(pB1,14)};
    SBAR(); pv(o,vb0+2*sl_cur,PAF(0),PAF(1),PAF(2),PAF(3)); pv(o+2,vb0+2*sl_cur+8192,PAF(0),PAF(1),PAF(2),PAF(3)); }
  #undef PKW
  #undef PAF
  #undef VFR
  #undef PIN
  #undef MX3
  #undef GAPA
  #undef GAPB
  #undef GAPB2
  #undef EX
  #undef VRD
  #undef VRD2
  #undef KRD
  #undef STEP
  #undef ENDW
  {auto rr=__builtin_amdgcn_permlane32_swap(__float_as_uint(l_reg),__float_as_uint(l_reg),false,false);l_reg=__uint_as_float(rr[0])+__uint_as_float(rr[1]);}
  if(hi==0)wsf[32+r32]=l_reg;asm volatile("s_waitcnt lgkmcnt(0)":::"memory");
  float rli[16];
  #pragma unroll
  for(int r=0;r<16;++r)rli[r]=__builtin_amdgcn_rcpf(wsf[32+crow(r,hi)]);
  bf16*Ow=O+(rowbase+q0+wid*QBLK)*PO+ocol;
  { bf16*stg=(bf16*)(shm+LDS_OST)+wid*2048;
    #pragma unroll
    for(int hf=0;hf<2;++hf){
      #pragma unroll
      for(int r=0;r<16;++r){const int orow=crow(r,hi);
        #pragma unroll
        for(int d0=0;d0<2;++d0)stg[orow*64+d0*32+r32]=__float2bfloat16(o[2*hf+d0][r]*rli[r]);}
      asm volatile("s_waitcnt lgkmcnt(0)":::"memory");
      #pragma unroll
      for(int i=0;i<4;++i){const int row=i*8+(lane>>3),ch=lane&7; const u32x4 v=*(const u32x4*)(stg+row*64+ch*8); ATTN_STORE16(Ow+(long)row*PO+hf*64+ch*8,v);}
      asm volatile("s_waitcnt lgkmcnt(0)":::"memory"); } }
  asm volatile("s_waitcnt lgkmcnt(0)\n\ts_barrier":::"memory");
  #undef DMA_K
  #undef DMA_V
  #undef CMASK
  #undef START
  #undef RESC
  #undef ROT
}
constexpr int ATTN_LDS_BYTES=LDS_BYTES;
#undef SBAR
#undef WAIT_BAR
}
#define LAS __attribute__((address_space(3)))
typedef unsigned short bf16_t;
typedef float f32x4 __attribute__((ext_vector_type(4)));
typedef unsigned u32x4 __attribute__((ext_vector_type(4)));
typedef unsigned u32x2 __attribute__((ext_vector_type(2)));

constexpr int NB = 4, SEQ = 4096, M = NB * SEQ, D = 1024, DIN = 3584, FF = 2816, DEPTH = 4;
constexpr int C_Q = 0, C_K = 512, C_V = 1024, C_HQ = 1536, C_F = 2048, C_I = 2560, C_G = 3072;
constexpr size_t MiB = 1u << 20;
constexpr size_t WS_WIN = 1 * MiB, WS_WOUT = 8 * MiB, WS_WGU = 10 * MiB, WS_WDN = 21 * MiB, WS_SS = 27 * MiB, WS_XG = 28 * MiB, WS_PROJ = 60 * MiB, WS_MIX = 172 * MiB, WS_ST = 204 * MiB, WS_END = 236 * MiB;
constexpr int NWAVES = 8, NTHR = 512, LDS_BYTES = 147456, MISC_OFF = 139264;
constexpr size_t WS_BAR = 768 * 1024, BAR_BYTES = 16384;
constexpr float NORM_EPS = 1e-6f, LOG2E = 1.4426950408889634f;
#ifndef HGRN_NAIVE
#define HGRN_NAIVE 0
#endif
#ifndef DUPMASK
#define DUPMASK 0
#endif
#define NREP(k) (((DUPMASK >> (k)) & 1) ? 2 : 1)
#ifndef PHMASK
#define PHMASK 255
#endif
constexpr int PH_PER_LAYER = 8, N_PHASES = DEPTH * PH_PER_LAYER;

__device__ __forceinline__ unsigned f2bf(float f) { unsigned u = __builtin_bit_cast(unsigned, f); return (u + 0x7fffu + ((u >> 16) & 1u)) >> 16; }
__device__ __forceinline__ unsigned pk2(float lo, float hi) { return f2bf(lo) | (f2bf(hi) << 16); }
__device__ __forceinline__ float bf2f(bf16_t b) { return __builtin_bit_cast(float, (unsigned)b << 16); }
__device__ __forceinline__ float bflo(unsigned w) { return __builtin_bit_cast(float, w << 16); }
__device__ __forceinline__ float bfhi(unsigned w) { return __builtin_bit_cast(float, w & 0xffff0000u); }
__device__ __forceinline__ float wave_sum(float v) {
#pragma unroll
    for (int o = 1; o < 64; o <<= 1) v += __shfl_xor(v, o);
    return v;
}
__device__ __forceinline__ float sigmoid_f(float v) { return __builtin_amdgcn_rcpf(1.f + __expf(-v)); }
__device__ __forceinline__ float silu_f(float v) { return v * sigmoid_f(v); }

__device__ __forceinline__ float row_rstd(const float* ss, int row, int fq) {
    const f32x4 v = *(const f32x4*)(ss + (size_t)row * 16 + fq * 4);
    float s = (v.x + v.y) + (v.z + v.w);
    s += __shfl_xor(s, 16); s += __shfl_xor(s, 32);
    return rsqrtf(s * (1.f / D) + NORM_EPS);
}

#define XB_TMO      128
#define XB_XCNT(j)  (256  + 64 * (j))
#define XB_XSUB(j)  (1280 + 64 * (j))
#define XB_XGEN(j)  (2304 + 64 * (j))
#define XB_TOP      3328
#define XB_TOPGEN   3392
#define XCD_BAR_WORDS 3456
#define XB_SPIN_CAP (1u << 18)

__device__ __forceinline__ unsigned xb_ld(unsigned* p)              { return __hip_atomic_load(p, __ATOMIC_RELAXED, __HIP_MEMORY_SCOPE_AGENT); }
__device__ __forceinline__ unsigned xb_add(unsigned* p, unsigned v) { return __hip_atomic_fetch_add(p, v, __ATOMIC_RELAXED, __HIP_MEMORY_SCOPE_AGENT); }
__device__ __forceinline__ unsigned xb_xcc_id() { return (unsigned)__builtin_amdgcn_s_getreg((3 << 11) | 20) & 0xFu; }
#define XB_SPIN(cond, bar) do { unsigned _sp = 0; while (cond) { __builtin_amdgcn_s_sleep(1); \
    if ((++_sp & 255u) == 0u) { if (xb_ld(&(bar)[XB_TMO])) break; if (_sp > XB_SPIN_CAP) { atomicAdd(&(bar)[XB_TMO], 1u); break; } } } } while (0)

struct XcdBarrier {
    unsigned* bar; unsigned x;
    volatile LAS unsigned* st;
};

__device__ __forceinline__ XcdBarrier xcd_barrier_post(unsigned* bar, volatile LAS unsigned* st) {
    XcdBarrier b; b.bar = bar; b.x = xb_xcc_id(); b.st = st;
    if (threadIdx.x == 0) (void)xb_add(&bar[XB_XCNT(b.x)], 1u);
    return b;
}
__device__ __forceinline__ void xcd_barrier_complete(unsigned* bar, unsigned x, unsigned& nloc, unsigned& nx) {
    const unsigned G = gridDim.x * gridDim.y * gridDim.z;
    unsigned sum, cnt, mine, sp = 0u;
    for (;;) {
        sum = 0u; cnt = 0u; mine = 0u;
#pragma unroll
        for (unsigned j = 0; j < 16; ++j) { const unsigned c = xb_ld(&bar[XB_XCNT(j)]); sum += c; cnt += (c > 0u) ? 1u : 0u; mine = (j == x) ? c : mine; }
        if (sum == G) break;
        __builtin_amdgcn_s_sleep(1);
        if ((++sp & 255u) == 0u) { if (xb_ld(&bar[XB_TMO])) break; if (sp > XB_SPIN_CAP) { atomicAdd(&bar[XB_TMO], 1u); break; } }
    }
    nloc = mine > 0u ? mine : 1u; nx = cnt > 0u ? cnt : 1u;
}

__device__ __forceinline__ void xcd_barrier(const XcdBarrier& b) {
    asm volatile("s_waitcnt vmcnt(0)" ::: "memory");
    __syncthreads();
    if (threadIdx.x == 0) {
        unsigned* bar = b.bar;
        __builtin_amdgcn_s_waitcnt(0);
        unsigned nloc = b.st[0], nx = b.st[1];
        if (nloc == 0u) { xcd_barrier_complete(bar, b.x, nloc, nx); b.st[0] = nloc; b.st[1] = nx; }
        const unsigned old = xb_add(&bar[XB_XSUB(b.x)], 1u);
        const unsigned gen = old / nloc;
        if (old + 1u == (gen + 1u) * nloc) {
            __builtin_amdgcn_fence(__ATOMIC_RELEASE, "agent");
            asm volatile("s_waitcnt vmcnt(0)" ::: "memory");
            const unsigned og = xb_add(&bar[XB_TOP], 1u);
            const unsigned tg = og / nx;
            if (og + 1u == (tg + 1u) * nx) xb_add(&bar[XB_TOPGEN], 1u);
            else XB_SPIN(xb_ld(&bar[XB_TOPGEN]) == tg, bar);
            __builtin_amdgcn_fence(__ATOMIC_ACQUIRE, "agent");
            xb_add(&bar[XB_XGEN(b.x)], 1u);
            asm volatile("s_waitcnt vmcnt(0)" ::: "memory");
        } else {
            XB_SPIN(xb_ld(&bar[XB_XGEN(b.x)]) == gen, bar);
            __builtin_amdgcn_fence(__ATOMIC_ACQUIRE, "agent");
            asm volatile("s_waitcnt vmcnt(0)" ::: "memory");
        }
    }
    __syncthreads();
}


constexpr int RSTD_OFF = 131072, LBT_OFF = 131072 + 1024, QKG_OFF = 131072 + 3072;
constexpr int XCH_A = QKG_OFF + 512, XCH_B = MISC_OFF + 64;
static_assert(XCH_A + 4096 <= MISC_OFF && XCH_B + 4096 <= LDS_BYTES, "LDS map above the GEMM stage region");
__device__ __forceinline__ void build_row_tables(LAS unsigned char* lds, const float* ss, int pm, const float* lbp, int layer, int tid, const float* qg = nullptr, const float* kg = nullptr) {
    { const int row = tid >> 1, half = tid & 1; const float* p = ss + (size_t)(pm * 256 + row) * 16 + half * 8;
      const f32x4 a = *(const f32x4*)p, b = *(const f32x4*)(p + 4);
      float s = ((a.x + a.y) + (a.z + a.w)) + ((b.x + b.y) + (b.z + b.w));
      s += __shfl_xor(s, 1);
      if (half == 0) ((LAS float*)(lds + RSTD_OFF))[row] = rsqrtf(s * (1.f / D) + NORM_EPS); }
    if (lbp && layer > 0) {
        const int c = tid;
        const float a0 = lbp[c], a1 = lbp[512 + c], a2 = lbp[1024 + c], a3 = lbp[1536 + c];
        const float mx = fmaxf(fmaxf(a0, a1), fmaxf(a2, a3));
        const float e0 = __expf(a0 - mx), e1 = __expf(a1 - mx), e2 = __expf(a2 - mx), e3 = __expf(a3 - mx);
        float cum = e1; if (layer >= 2) cum += e2; if (layer >= 3) cum += e3;
        ((LAS float*)(lds + LBT_OFF))[c] = cum / ((e0 + e1) + (e2 + e3));
    }
    if (qg && tid < 128) ((LAS float*)(lds + QKG_OFF))[tid] = (tid < 64) ? qg[tid] * (0.125f * LOG2E) : kg[tid - 64];
    __syncthreads();
}

template <bool TAB> struct EpiA {
    static constexpr bool PERM = true, AFTER_DRAIN = false;
    bf16_t* proj; const float* ss; const float* lbp; int layer; const LAS float* rtab; const LAS float* lbtab; LAS unsigned char* xlds;
    __device__ __forceinline__ void operator()(const pg8::f32x4 (&acc)[2][2][4][2], const pg8::Unit& u, int wr, int wc, int fr, int fq) const {
        const int seg = u.pn >> 1;
        const int row0 = u.pm * 256 + wr * 64 + fr, colb = u.pn * 256 + wc * 32 + 8 * fq;
        if constexpr (TAB) if (seg < 2) {
            typedef float f32x2e __attribute__((ext_vector_type(2)));
            float ps[2][4][2];
#pragma unroll
            for (int ai = 0; ai < 2; ++ai)
#pragma unroll
                for (int m = 0; m < 4; ++m) { const float rs0 = rtab[wr * 64 + fr + ai * 128 + m * 16];
#pragma unroll
                    for (int bj = 0; bj < 2; ++bj) { const pg8::f32x4 a0 = acc[ai][bj][m][0], a1 = acc[ai][bj][m][1];
                        float s = ((a0[0] * a0[0] + a0[1] * a0[1]) + (a0[2] * a0[2] + a0[3] * a0[3])) + ((a1[0] * a1[0] + a1[1] * a1[1]) + (a1[2] * a1[2] + a1[3] * a1[3]));
                        s += __shfl_xor(s, 16); s += __shfl_xor(s, 32); ps[ai][m][bj] = s * (rs0 * rs0); } }
            const int wv = wr * 4 + wc;
            LAS float* X = (LAS float*)(xlds + (wv < 4 ? XCH_A + wv * 1024 : XCH_B + (wv - 4) * 1024));
            const LAS float* Y = (const LAS float*)(xlds + ((wv ^ 1) < 4 ? XCH_A + (wv ^ 1) * 1024 : XCH_B + ((wv ^ 1) - 4) * 1024));
            if (fq == 0) {
#pragma unroll
                for (int ai = 0; ai < 2; ++ai)
#pragma unroll
                    for (int m = 0; m < 4; ++m)
#pragma unroll
                        for (int bj = 0; bj < 2; ++bj) X[((ai * 4 + m) * 2 + bj) * 16 + fr] = ps[ai][m][bj];
            }
            asm volatile("s_waitcnt lgkmcnt(0)\n\ts_barrier" ::: "memory");
            const LAS float* gp = (const LAS float*)(xlds + QKG_OFF) + seg * 64 + (wc & 1) * 32 + 8 * fq;
            const f32x4 g0 = *(const LAS f32x4*)gp, g1 = *(const LAS f32x4*)(gp + 4);
#pragma unroll
            for (int ai = 0; ai < 2; ++ai)
#pragma unroll
                for (int m = 0; m < 4; ++m) {
                    const int row = row0 + ai * 128 + m * 16; const float rs1 = rtab[wr * 64 + fr + ai * 128 + m * 16];
#pragma unroll
                    for (int bj = 0; bj < 2; ++bj) {
                        const float tot = ps[ai][m][bj] + Y[((ai * 4 + m) * 2 + bj) * 16 + fr];
                        const float r = rsqrtf(tot * (1.f / 64.f) + NORM_EPS) * rs1;
                        const pg8::f32x4 a0 = acc[ai][bj][m][0] * r * g0, a1 = acc[ai][bj][m][1] * r * g1;
                        u32x4 w; w.x = pg8::cvt_pk_bf16(a0[0], a0[1]); w.y = pg8::cvt_pk_bf16(a0[2], a0[3]); w.z = pg8::cvt_pk_bf16(a1[0], a1[1]); w.w = pg8::cvt_pk_bf16(a1[2], a1[3]);
                        *(u32x4*)(proj + (size_t)row * DIN + colb + bj * 128) = w;
                    }
                }
            return;
        }
        float lb[2][8];
#pragma unroll
        for (int bj = 0; bj < 2; ++bj)
#pragma unroll
            for (int j = 0; j < 8; ++j) lb[bj][j] = 0.f;
        if (seg == 4 && layer > 0) {
            if constexpr (TAB) {
#pragma unroll
                for (int bj = 0; bj < 2; ++bj) { const f32x4 t0 = *(const LAS f32x4*)(lbtab + colb + bj * 128 - C_F), t1 = *(const LAS f32x4*)(lbtab + colb + bj * 128 - C_F + 4);
#pragma unroll
                    for (int j = 0; j < 4; ++j) { lb[bj][j] = t0[j]; lb[bj][4 + j] = t1[j]; } }
            } else {
#pragma unroll
                for (int bj = 0; bj < 2; ++bj)
#pragma unroll
                    for (int j = 0; j < 8; ++j) {
                        const int c = colb + bj * 128 + j - C_F;
                        const float a0 = lbp[c], a1 = lbp[512 + c], a2 = lbp[1024 + c], a3 = lbp[1536 + c];
                        const float mx = fmaxf(fmaxf(a0, a1), fmaxf(a2, a3));
                        const float e0 = __expf(a0 - mx), e1 = __expf(a1 - mx), e2 = __expf(a2 - mx), e3 = __expf(a3 - mx);
                        float cum = e1; if (layer >= 2) cum += e2; if (layer >= 3) cum += e3;
                        lb[bj][j] = cum / ((e0 + e1) + (e2 + e3));
                    }
            }
        }
#pragma unroll
        for (int ai = 0; ai < 2; ++ai)
#pragma unroll
            for (int m = 0; m < 4; ++m) {
                const int row = row0 + ai * 128 + m * 16;
                float rstd; if constexpr (TAB) rstd = rtab[row - u.pm * 256]; else rstd = row_rstd(ss, row, fq);
#pragma unroll
                for (int bj = 0; bj < 2; ++bj) {
                    typedef float f32x2e __attribute__((ext_vector_type(2)));
                    f32x2e x2[4];
#pragma unroll
                    for (int q = 0; q < 4; ++q) { const pg8::f32x4 a = acc[ai][bj][m][q >> 1]; x2[q] = ((q & 1) ? (f32x2e){a[2], a[3]} : (f32x2e){a[0], a[1]}) * rstd; }
                    if (seg == 3 || seg == 6) {
#pragma unroll
                        for (int q = 0; q < 4; ++q) { const f32x2e t = x2[q] * (-LOG2E); f32x2e e; e.x = __builtin_amdgcn_exp2f(t.x); e.y = __builtin_amdgcn_exp2f(t.y);
                            const f32x2e d = e + 1.0f; f32x2e rc; rc.x = __builtin_amdgcn_rcpf(d.x); rc.y = __builtin_amdgcn_rcpf(d.y); x2[q] = x2[q] * rc; }
                    } else if (seg == 4) {
                        if (layer == 0) {
#pragma unroll
                            for (int q = 0; q < 4; ++q) { const f32x2e z = x2[q], t = __builtin_elementwise_abs(z) * (-LOG2E); f32x2e e; e.x = __builtin_amdgcn_exp2f(t.x); e.y = __builtin_amdgcn_exp2f(t.y);
                                const f32x2e d = e + 1.0f; f32x2e lg; lg.x = __builtin_amdgcn_logf(d.x); lg.y = __builtin_amdgcn_logf(d.y);
                                x2[q] = __builtin_elementwise_min(z, (f32x2e){0.f, 0.f}) - lg * 0.6931471805599453f; }
                        } else {
#pragma unroll
                            for (int q = 0; q < 4; ++q) { const f32x2e t = x2[q] * (-LOG2E); f32x2e e; e.x = __builtin_amdgcn_exp2f(t.x); e.y = __builtin_amdgcn_exp2f(t.y);
                                const f32x2e d = e + 1.0f; f32x2e rc; rc.x = __builtin_amdgcn_rcpf(d.x); rc.y = __builtin_amdgcn_rcpf(d.y);
                                const f32x2e l2 = (f32x2e){lb[bj][2 * q], lb[bj][2 * q + 1]}, a = l2 + (1.0f - l2) * rc; f32x2e lg; lg.x = __builtin_amdgcn_logf(a.x); lg.y = __builtin_amdgcn_logf(a.y);
                                x2[q] = lg * 0.6931471805599453f; }
                        }
                    }
                    u32x4 w; w.x = pg8::cvt_pk_bf16(x2[0].x, x2[0].y); w.y = pg8::cvt_pk_bf16(x2[1].x, x2[1].y); w.z = pg8::cvt_pk_bf16(x2[2].x, x2[2].y); w.w = pg8::cvt_pk_bf16(x2[3].x, x2[3].y);
                    *(u32x4*)(proj + (size_t)row * DIN + colb + bj * 128) = w;
                }
            }
    }
};
template <bool BASE_F32, bool LAST> struct EpiRes {
    static constexpr bool PERM = true, AFTER_DRAIN = false;
    const float* basef; bf16_t* xres; float* outf; float* ss;
    __device__ __forceinline__ void operator()(const pg8::f32x4 (&acc)[2][2][4][2], const pg8::Unit& u, int wr, int wc, int fr, int fq) const {
        const int row0 = u.pm * 256 + wr * 64 + fr, colb = u.pn * 256 + wc * 32 + 8 * fq;
#pragma unroll
        for (int ai = 0; ai < 2; ++ai)
#pragma unroll
            for (int m = 0; m < 4; ++m) {
                const int row = row0 + ai * 128 + m * 16; float s = 0.f;
#pragma unroll
                for (int bj = 0; bj < 2; ++bj) {
                    const size_t off = (size_t)row * D + colb + bj * 128;
                    f32x4 b0, b1;
                    if constexpr (BASE_F32) { b0 = __builtin_nontemporal_load((const f32x4*)(basef + off)); b1 = __builtin_nontemporal_load((const f32x4*)(basef + off + 4)); }
                    else { const u32x4 w = *(const u32x4*)(xres + off); b0 = (f32x4){bflo(w.x), bfhi(w.x), bflo(w.y), bfhi(w.y)}; b1 = (f32x4){bflo(w.z), bfhi(w.z), bflo(w.w), bfhi(w.w)}; }
                    const f32x4 v0 = acc[ai][bj][m][0] + b0, v1 = acc[ai][bj][m][1] + b1;
                    if constexpr (LAST) { *(f32x4*)(outf + off) = v0; *(f32x4*)(outf + off + 4) = v1; }
                    else {
                        s += (v0.x * v0.x + v0.y * v0.y) + (v0.z * v0.z + v0.w * v0.w) + (v1.x * v1.x + v1.y * v1.y) + (v1.z * v1.z + v1.w * v1.w);
                        u32x4 w; w.x = pg8::cvt_pk_bf16(v0.x, v0.y); w.y = pg8::cvt_pk_bf16(v0.z, v0.w); w.z = pg8::cvt_pk_bf16(v1.x, v1.y); w.w = pg8::cvt_pk_bf16(v1.z, v1.w);
                        *(u32x4*)(xres + off) = w; }
                }
                if constexpr (!LAST) { s += __shfl_xor(s, 16); s += __shfl_xor(s, 32); if (fq == 0) ss[(size_t)row * 16 + u.pn * 4 + wc] = s; }
            }
    }
};
template <bool TAB> struct EpiGU {
    static constexpr bool PERM = true, AFTER_DRAIN = false;
    bf16_t* h; const float* ss; const LAS float* rtab;
    __device__ __forceinline__ void operator()(const pg8::f32x4 (&acc)[2][2][4][2], const pg8::Unit& u, int wr, int wc, int fr, int fq) const {
        const int row0 = u.pm * 256 + wr * 64 + fr, col = u.pn * 128 + wc * 32 + 8 * fq;
#pragma unroll
        for (int ai = 0; ai < 2; ++ai)
#pragma unroll
            for (int m = 0; m < 4; ++m) {
                const int row = row0 + ai * 128 + m * 16;
                float rstd; if constexpr (TAB) rstd = rtab[row - u.pm * 256]; else rstd = row_rstd(ss, row, fq);
                const float nl = -rstd * LOG2E, r2 = rstd * rstd;
                typedef float f32x2e __attribute__((ext_vector_type(2)));
                f32x2e o2[4];
#pragma unroll
                for (int q = 0; q < 4; ++q) {
                    const pg8::f32x4 gq = acc[ai][0][m][q >> 1], uq = acc[ai][1][m][q >> 1];
                    const f32x2e g2 = (q & 1) ? (f32x2e){gq[2], gq[3]} : (f32x2e){gq[0], gq[1]}, u2 = (q & 1) ? (f32x2e){uq[2], uq[3]} : (f32x2e){uq[0], uq[1]};
                    const f32x2e t = g2 * nl; f32x2e e; e.x = __builtin_amdgcn_exp2f(t.x); e.y = __builtin_amdgcn_exp2f(t.y);
                    const f32x2e d = e + 1.0f; f32x2e rc; rc.x = __builtin_amdgcn_rcpf(d.x); rc.y = __builtin_amdgcn_rcpf(d.y);
                    o2[q] = ((g2 * u2) * r2) * rc;
                }
                u32x4 w; w.x = pg8::cvt_pk_bf16(o2[0].x, o2[0].y); w.y = pg8::cvt_pk_bf16(o2[1].x, o2[1].y); w.z = pg8::cvt_pk_bf16(o2[2].x, o2[2].y); w.w = pg8::cvt_pk_bf16(o2[3].x, o2[3].y);
                *(u32x4*)(h + (size_t)row * FF + col) = w;
            }
    }
};

__device__ __forceinline__ void convert_macro(const float* __restrict__ W, const float* __restrict__ gk, int K, int N, bf16_t* WT, int k0, int n0, int mode, LAS float* scr, int tid) {
    float r[32];
#pragma unroll
    for (int i = 0; i < 32; ++i) r[i] = __builtin_nontemporal_load(W + (size_t)(k0 + i * 2 + (tid >> 8)) * N + n0 + (tid & 255));
#pragma unroll
    for (int i = 0; i < 32; ++i) { const int k = i * 2 + (tid >> 8); scr[k * 257 + (tid & 255)] = r[i] * (gk ? gk[k0 + k] : 1.f); }
    __syncthreads();
    const int c = tid & 7;
#pragma unroll
    for (int j = 0; j < 4; ++j) {
        const int nn = (tid >> 3) + 64 * j, nb = n0 + 64 * j;
        const int drow = (mode == 0) ? nb + (tid >> 3) : (nb / 128) * 256 + (nb % 128) + (mode == 2 ? 128 : 0) + (tid >> 3);
        const LAS float* s = scr + (8 * c) * 257 + nn;
        u32x4 o; o.x = pk2(s[0], s[257]); o.y = pk2(s[514], s[771]); o.z = pk2(s[1028], s[1285]); o.w = pk2(s[1542], s[1799]);
        *(u32x4*)(WT + (size_t)drow * K + k0 + 8 * c) = o;
    }
    __syncthreads();
}
constexpr int CV_IN = 16 * 14, CV_OUT = 16 * 4, CV_G = 16 * 11, CV_DN = 44 * 4;

template <int R> __device__ __forceinline__ void prologue_rows(const float* xrow, bf16_t* xgrow, float* ssrow, int lane) {
    f32x4 v[R][4];
#pragma unroll
    for (int q = 0; q < R; ++q)
#pragma unroll
        for (int j = 0; j < 4; ++j) v[q][j] = __builtin_nontemporal_load((const f32x4*)(xrow + (size_t)q * D) + lane + 64 * j);
#pragma unroll
    for (int q = 0; q < R; ++q) {
        float s = 0.f;
#pragma unroll
        for (int j = 0; j < 4; ++j) { const f32x4 w = v[q][j]; s += (w.x * w.x + w.y * w.y) + (w.z * w.z + w.w * w.w);
            u32x2 o; o.x = pk2(w.x, w.y); o.y = pk2(w.z, w.w); ((u32x2*)(xgrow + (size_t)q * D))[lane + 64 * j] = o; }
        s = wave_sum(s);
        if (lane < 16) ssrow[q * 16 + lane] = (lane == 0) ? s : 0.f;
    }
}
template <int R> __device__ __forceinline__ void qknorm_rows(bf16_t* prow, const float* qg, const float* kg, int lane) {
    bf16_t* p = prow + lane * 16;
    u32x4 a[R], b[R];
#pragma unroll
    for (int q = 0; q < R; ++q) { a[q] = *(const u32x4*)(p + (size_t)q * DIN); b[q] = *(const u32x4*)(p + (size_t)q * DIN + 8); }
    const float* g = (lane < 32 ? qg : kg) + (lane & 3) * 16;
    float gv[16];
#pragma unroll
    for (int i = 0; i < 16; ++i) gv[i] = g[i];
#pragma unroll
    for (int q = 0; q < R; ++q) {
        float v[16];
#pragma unroll
        for (int i = 0; i < 4; ++i) { v[2 * i] = bflo(a[q][i]); v[2 * i + 1] = bfhi(a[q][i]); v[8 + 2 * i] = bflo(b[q][i]); v[8 + 2 * i + 1] = bfhi(b[q][i]); }
        float s = 0.f;
#pragma unroll
        for (int i = 0; i < 16; ++i) s += v[i] * v[i];
        s += __shfl_xor(s, 1); s += __shfl_xor(s, 2);
        const float r = rsqrtf(s * (1.f / 64.f) + NORM_EPS) * (lane < 32 ? 0.125f * LOG2E : 1.f);
        u32x4 oa, ob;
#pragma unroll
        for (int i = 0; i < 4; ++i) { oa[i] = pk2(v[2 * i] * r * gv[2 * i], v[2 * i + 1] * r * gv[2 * i + 1]); ob[i] = pk2(v[8 + 2 * i] * r * gv[8 + 2 * i], v[8 + 2 * i + 1] * r * gv[8 + 2 * i + 1]); }
        *(u32x4*)(p + (size_t)q * DIN) = oa; *(u32x4*)(p + (size_t)q * DIN + 8) = ob;
    }
}
template <int R> __device__ __forceinline__ void combine_rows(const bf16_t* Orow, bf16_t* mixrow, const float* subg, float lam, float oscale, int lane) {
    const int h = lane >> 4, d0 = (lane & 15) * 8;
    u32x4 a[R], b[R];
#pragma unroll
    for (int q = 0; q < R; ++q) { a[q] = *(const u32x4*)(Orow + (size_t)q * D + (2 * h) * 128 + d0); b[q] = *(const u32x4*)(Orow + (size_t)q * D + (2 * h + 1) * 128 + d0); }
    const f32x4 g0 = *(const f32x4*)(subg + d0), g1 = *(const f32x4*)(subg + d0 + 4);
    const float gv[8] = {g0.x, g0.y, g0.z, g0.w, g1.x, g1.y, g1.z, g1.w};
#pragma unroll
    for (int q = 0; q < R; ++q) {
        float v[8]; float s = 0.f;
#pragma unroll
        for (int i = 0; i < 4; ++i) { v[2 * i] = bflo(a[q][i]) - lam * bflo(b[q][i]); v[2 * i + 1] = bfhi(a[q][i]) - lam * bfhi(b[q][i]); }
#pragma unroll
        for (int i = 0; i < 8; ++i) s += v[i] * v[i];
        s += __shfl_xor(s, 1); s += __shfl_xor(s, 2); s += __shfl_xor(s, 4); s += __shfl_xor(s, 8);
        const float r = rsqrtf(s * (1.f / 128.f) + NORM_EPS) * oscale;
        u32x4 o;
#pragma unroll
        for (int i = 0; i < 4; ++i) o[i] = pk2(v[2 * i] * r * gv[2 * i], v[2 * i + 1] * r * gv[2 * i + 1]);
        *(u32x4*)(mixrow + (size_t)q * D + h * 128 + d0) = o;
    }
}
#if HGRN_NAIVE
__device__ __forceinline__ void hgrn_norm_row(bf16_t* mixrow, const bf16_t* projrow, const float* hg, int lane) {
    const int h = lane >> 4, d0 = (lane & 15) * 8;
    const u32x4 c = *(const u32x4*)(mixrow + 512 + h * 128 + d0), gg = *(const u32x4*)(projrow + C_G + h * 128 + d0);
    float v[8]; float s = 0.f;
#pragma unroll
    for (int i = 0; i < 4; ++i) { v[2 * i] = bflo(c[i]); v[2 * i + 1] = bfhi(c[i]); }
#pragma unroll
    for (int i = 0; i < 8; ++i) s += v[i] * v[i];
    s += __shfl_xor(s, 1); s += __shfl_xor(s, 2); s += __shfl_xor(s, 4); s += __shfl_xor(s, 8);
    const float r = rsqrtf(s * (1.f / 128.f) + NORM_EPS);
    u32x4 o;
#pragma unroll
    for (int i = 0; i < 4; ++i) o[i] = pk2(v[2 * i] * r * hg[d0 + 2 * i] * bflo(gg[i]), v[2 * i + 1] * r * hg[d0 + 2 * i + 1] * bfhi(gg[i]));
    *(u32x4*)(mixrow + 512 + h * 128 + d0) = o;
}
#endif
__device__ __forceinline__ void hgrn_naive(LAS float* sm, const bf16_t* proj, bf16_t* mix, int bh, int tid) {
    const int b = bh >> 2, h = bh & 3;
    LAS float* sf = sm; LAS float* sk = sm + 2048; LAS float* sq = sm + 4096; LAS float* sv = sm + 6144; LAS float* so = sm + 8192;
    const int v = tid & 127, kq = tid >> 7;
    float S[32];
#pragma unroll
    for (int j = 0; j < 32; ++j) S[j] = 0.f;
    for (int t0 = 0; t0 < SEQ; t0 += 16) {
        for (int e = tid; e < 2048; e += NTHR) { const int tt = e >> 7, k = e & 127; const bf16_t* r = proj + (size_t)(b * SEQ + t0 + tt) * DIN + h * 128 + k;
            const float lf = bf2f(r[C_F]); sf[e] = __expf(lf); sk[e] = -expm1f(lf); sq[e] = bf2f(r[C_HQ]); sv[e] = bf2f(r[C_I]); }
        __syncthreads();
        for (int tt = 0; tt < 16; ++tt) { float acc = 0.f; const float vv = sv[tt * 128 + v];
#pragma unroll
            for (int j = 0; j < 32; ++j) { const int k = tt * 128 + kq * 32 + j; S[j] = sf[k] * S[j] + sk[k] * vv; acc += sq[k] * S[j]; }
            so[(tt * 4 + kq) * 128 + v] = acc; }
        __syncthreads();
        for (int e = tid; e < 2048; e += NTHR) { const int tt = e >> 7, vc = e & 127;
            const float o = (so[(tt * 4 + 0) * 128 + vc] + so[(tt * 4 + 1) * 128 + vc]) + (so[(tt * 4 + 2) * 128 + vc] + so[(tt * 4 + 3) * 128 + vc]);
            mix[(size_t)(b * SEQ + t0 + tt) * D + 512 + h * 128 + vc] = (bf16_t)f2bf(o); }
    }
    __syncthreads();
}


typedef short hbf16x8 __attribute__((ext_vector_type(8)));
typedef float hf32x16 __attribute__((ext_vector_type(16)));
constexpr int HS_K = 272, HS_V = 144;
constexpr int HL_BF = 0, HL_QD = 32768, HL_KD = HL_QD + 64 * HS_K, HL_KO = HL_KD + 64 * HS_K, HL_QE = HL_KO + 32 * HS_K, HL_VT = HL_QE + 32 * HS_K, HL_KT = HL_VT + 128 * HS_V,
              HL_TOT = HL_KT + 128 * HS_V, HL_PART = HL_TOT + 2048, HL_END = HL_PART + 1024;
static_assert(HL_END <= 131072, "HGRN LDS map");
__device__ __forceinline__ int crow16(int r, int hi) { return (r & 3) + 8 * (r >> 2) + 4 * hi; }

__device__ __forceinline__ void hgrn_load1(const bf16_t* proj, int b, int h, int ch, int tid, unsigned short (&lr)[16], unsigned short (&vr)[16]) {
    const int col = tid & 127, seg = tid >> 7;
    const bf16_t* base = proj + (size_t)(b * SEQ + ch * 64 + seg * 16) * DIN + h * 128 + col;
#pragma unroll
    for (int i = 0; i < 16; ++i) { lr[i] = base[(size_t)i * DIN + C_F]; vr[i] = base[(size_t)i * DIN + C_I]; }
}
__device__ __forceinline__ void hgrn_pass1(LAS unsigned char* L, int tid, const unsigned short (&lr)[16], const unsigned short (&vr)[16], float (&cum)[16], float (&lf)[16], float& blast) {
    const int col = tid & 127, seg = tid >> 7;
    float cs = 0.f;
#pragma unroll
    for (int i = 0; i < 16; ++i) { lf[i] = bf2f(lr[i]); cs += lf[i]; cum[i] = cs; }
    LAS float* TOT = (LAS float*)(L + HL_TOT);
    TOT[seg * 128 + col] = cs;
    { u32x4 w0, w1;
#pragma unroll
      for (int i = 0; i < 4; ++i) { w0[i] = (unsigned)vr[2 * i] | ((unsigned)vr[2 * i + 1] << 16); w1[i] = (unsigned)vr[8 + 2 * i] | ((unsigned)vr[8 + 2 * i + 1] << 16); }
      LAS unsigned char* vp = L + HL_VT + col * HS_V + seg * 32;
      *(LAS u32x4*)vp = w0; *(LAS u32x4*)(vp + 16) = w1; }
    __syncthreads();
    const float t0 = TOT[col], t1 = TOT[128 + col], t2 = TOT[256 + col], t3 = TOT[384 + col];
    const float off = (seg > 0 ? t0 : 0.f) + (seg > 1 ? t1 : 0.f) + (seg > 2 ? t2 : 0.f);
    blast = (t0 + t1) + (t2 + t3);
#pragma unroll
    for (int i = 0; i < 16; ++i) cum[i] += off;
}
__device__ __forceinline__ void hgrn_stage1(LAS unsigned char* L, const bf16_t* proj, bf16_t* ST, float* Dbuf, int item, int tid) {
    const int bh = item >> 6, ch = item & 63, b = bh >> 2, h = bh & 3, col = tid & 127, seg = tid >> 7;
    const int lane = tid & 63, wave = __builtin_amdgcn_readfirstlane(tid >> 6), r = lane & 31, hh = lane >> 5;
    float cum[16], lf[16], blast;
    { unsigned short lr[16], vr[16]; hgrn_load1(proj, b, h, ch, tid, lr, vr); hgrn_pass1(L, tid, lr, vr, cum, lf, blast); }
    { u32x4 w0, w1; float ke[16];
#pragma unroll
      for (int i = 0; i < 16; ++i) ke[i] = (1.f - __expf(lf[i])) * __expf(blast - cum[i]);
#pragma unroll
      for (int i = 0; i < 4; ++i) { w0[i] = pk2(ke[2 * i], ke[2 * i + 1]); w1[i] = pk2(ke[8 + 2 * i], ke[8 + 2 * i + 1]); }
      LAS unsigned char* kp = L + HL_KT + col * HS_V + seg * 32;
      *(LAS u32x4*)kp = w0; *(LAS u32x4*)(kp + 16) = w1;
      if (seg == 0) Dbuf[(size_t)item * 128 + col] = __expf(blast); }
    __syncthreads();
    const int vb = wave & 3;
#pragma unroll
    for (int q = 0; q < 2; ++q) {
        const int kb = (wave >> 2) * 2 + q;
        hf32x16 acc = {};
        const LAS unsigned char* ap = L + HL_VT + (vb * 32 + r) * HS_V + hh * 16;
        const LAS unsigned char* bp = L + HL_KT + (kb * 32 + r) * HS_V + hh * 16;
#pragma unroll
        for (int s0 = 0; s0 < 4; ++s0) acc = __builtin_amdgcn_mfma_f32_32x32x16_bf16(*(const LAS hbf16x8*)(ap + s0 * 32), *(const LAS hbf16x8*)(bp + s0 * 32), acc, 0, 0, 0);
        bf16_t* out = ST + ((size_t)item * 128 + vb * 32) * 128 + kb * 32 + r;
#pragma unroll
        for (int g = 0; g < 16; ++g) out[(size_t)crow16(g, hh) * 128] = (bf16_t)f2bf(acc[g]);
    }
    __syncthreads();
}
typedef float hf32x2 __attribute__((ext_vector_type(2)));
__device__ __forceinline__ void hgrn_scan_row(bf16_t* ST, const float* Dbuf, int rowid, int lane) {
    const int bh = rowid >> 7, v = rowid & 127;
    unsigned* sp = (unsigned*)(ST + ((size_t)(bh * 64) * 128 + v) * 128) + lane;
    const hf32x2* dp = (const hf32x2*)(Dbuf + (size_t)(bh * 64) * 128) + lane;
    float s0 = 0.f, s1 = 0.f;
    for (int c0 = 0; c0 < 64; c0 += 16) {
        unsigned u[16]; hf32x2 d[16];
#pragma unroll
        for (int i = 0; i < 16; ++i) { u[i] = sp[(size_t)(c0 + i) * 8192]; d[i] = dp[(c0 + i) * 64]; }
#pragma unroll
        for (int i = 0; i < 16; ++i) { sp[(size_t)(c0 + i) * 8192] = pk2(s0, s1); s0 = d[i].x * s0 + bflo(u[i]); s1 = d[i].y * s1 + bfhi(u[i]); }
    }
}
__device__ __forceinline__ void hgrn_stage3(LAS unsigned char* L, const bf16_t* proj, const bf16_t* ST, bf16_t* mix, const float* hg, int item, int tid) {
    const int bh = item >> 6, ch = item & 63, b = bh >> 2, h = bh & 3, col = tid & 127, seg = tid >> 7;
    const int lane = tid & 63, wave = __builtin_amdgcn_readfirstlane(tid >> 6), r = lane & 31, hh = lane >> 5;
    const int vb = wave & 3, tb = wave >> 2;
    unsigned short lr[16], vr[16];
    hgrn_load1(proj, b, h, ch, tid, lr, vr);
    u32x4 qw2[2], fw2[2];
#pragma unroll
    for (int half = 0; half < 2; ++half) { const bf16_t* rowp = proj + (size_t)(b * SEQ + ch * 64 + (tid >> 4) + 32 * half) * DIN + h * 128 + (tid & 15) * 8;
        qw2[half] = *(const u32x4*)(rowp + C_HQ); fw2[half] = *(const u32x4*)(rowp + C_F); }
    hbf16x8 sfr[8];
    { const bf16_t* sg = ST + ((size_t)item * 128 + vb * 32 + r) * 128 + hh * 8;
#pragma unroll
      for (int kk = 0; kk < 8; ++kk) sfr[kk] = *(const hbf16x8*)(sg + kk * 16); }
    u32x2 gate2[4];
#pragma unroll
    for (int g = 0; g < 4; ++g) gate2[g] = *(const u32x2*)(proj + (size_t)(b * SEQ + ch * 64 + tb * 32 + r) * DIN + C_G + h * 128 + vb * 32 + 8 * g + 4 * hh);
    {
        float cum[16], lf[16], blast;
        hgrn_pass1(L, tid, lr, vr, cum, lf, blast);
        LAS float* BF = (LAS float*)(L + HL_BF);
#pragma unroll
        for (int i = 0; i < 16; ++i) BF[(seg * 16 + i) * 128 + col] = cum[i];
    }
    __syncthreads();
    {
        const int kvec = tid & 15;
        const LAS float* BF = (const LAS float*)(L + HL_BF);
        float b31[8];
        { const f32x4 x0 = *(const LAS f32x4*)(BF + 31 * 128 + kvec * 8), x1 = *(const LAS f32x4*)(BF + 31 * 128 + kvec * 8 + 4);
#pragma unroll
          for (int j = 0; j < 4; ++j) { b31[j] = x0[j]; b31[4 + j] = x1[j]; } }
#pragma unroll
        for (int half = 0; half < 2; ++half) {
            const int t = (tid >> 4) + 32 * half;
            const u32x4 qw = qw2[half], fw = fw2[half];
            const f32x4 y0 = *(const LAS f32x4*)(BF + t * 128 + kvec * 8), y1 = *(const LAS f32x4*)(BF + t * 128 + kvec * 8 + 4);
            float qd[8], kd[8], xx[8];
#pragma unroll
            for (int j = 0; j < 8; ++j) {
                const float q = (j & 1) ? bfhi(qw[j >> 1]) : bflo(qw[j >> 1]), lfj = (j & 1) ? bfhi(fw[j >> 1]) : bflo(fw[j >> 1]);
                const float bb = (j < 4) ? y0[j & 3] : y1[j & 3], kk = 1.f - __expf(lfj);
                const float rr = half ? b31[j] : 0.f;
                qd[j] = q * __expf(bb - rr); kd[j] = kk * __expf(fminf(rr - bb, 85.f));
                xx[j] = half ? q * __expf(bb) : kk * __expf(b31[j] - bb);
            }
            u32x4 w;
#pragma unroll
            for (int i = 0; i < 4; ++i) w[i] = pk2(qd[2 * i], qd[2 * i + 1]);
            *(LAS u32x4*)(L + HL_QD + t * HS_K + kvec * 16) = w;
#pragma unroll
            for (int i = 0; i < 4; ++i) w[i] = pk2(kd[2 * i], kd[2 * i + 1]);
            *(LAS u32x4*)(L + HL_KD + t * HS_K + kvec * 16) = w;
#pragma unroll
            for (int i = 0; i < 4; ++i) w[i] = pk2(xx[2 * i], xx[2 * i + 1]);
            *(LAS u32x4*)(L + (half ? HL_QE : HL_KO) + (t & 31) * HS_K + kvec * 16) = w;
        }
    }
    __syncthreads();
    hf32x16 o = {};
    for (int sb = 0; sb <= tb; ++sb) {
        hf32x16 X = {};
        const LAS unsigned char* ap = (sb == tb) ? (L + HL_KD + (sb * 32 + r) * HS_K + hh * 16) : (L + HL_KO + r * HS_K + hh * 16);
        const LAS unsigned char* bp = L + HL_QD + (tb * 32 + r) * HS_K + hh * 16;
#pragma unroll
        for (int kk = 0; kk < 8; ++kk) X = __builtin_amdgcn_mfma_f32_32x32x16_bf16(*(const LAS hbf16x8*)(ap + kk * 32), *(const LAS hbf16x8*)(bp + kk * 32), X, 0, 0, 0);
        if (sb == tb) {
#pragma unroll
            for (int g = 0; g < 16; ++g) if (crow16(g, hh) > r) X[g] = 0.f;
        }
#pragma unroll
        for (int sp = 0; sp < 2; ++sp) {
            u32x4 pw;
#pragma unroll
            for (int i = 0; i < 4; ++i) pw[i] = pk2(X[8 * sp + 2 * i], X[8 * sp + 2 * i + 1]);
            const LAS unsigned char* vp = L + HL_VT + (vb * 32 + r) * HS_V + (sb * 32 + 16 * sp + 4 * hh) * 2;
            const u32x2 lo = *(const LAS u32x2*)vp, hi = *(const LAS u32x2*)(vp + 16);
            u32x4 aw; aw.x = lo.x; aw.y = lo.y; aw.z = hi.x; aw.w = hi.y;
            o = __builtin_amdgcn_mfma_f32_32x32x16_bf16(__builtin_bit_cast(hbf16x8, aw), __builtin_bit_cast(hbf16x8, pw), o, 0, 0, 0);
        }
    }
    {
        const LAS unsigned char* qb = L + (tb ? HL_QE : HL_QD) + r * HS_K + hh * 16;
#pragma unroll
        for (int kk = 0; kk < 8; ++kk) o = __builtin_amdgcn_mfma_f32_32x32x16_bf16(sfr[kk], *(const LAS hbf16x8*)(qb + kk * 32), o, 0, 0, 0);
    }
    LAS float* PART = (LAS float*)(L + HL_PART);
    { float sq = 0.f;
#pragma unroll
      for (int g = 0; g < 16; ++g) sq += o[g] * o[g];
      sq += __shfl_xor(sq, 32);
      if (hh == 0) PART[vb * 64 + tb * 32 + r] = sq; }
    __syncthreads();
    {
        const int t = tb * 32 + r;
        const float tot = (PART[t] + PART[64 + t]) + (PART[128 + t] + PART[192 + t]);
        const float rstd = rsqrtf(tot * (1.f / 128.f) + NORM_EPS);
        const size_t row = (size_t)(b * SEQ + ch * 64 + t);
#pragma unroll
        for (int g = 0; g < 4; ++g) {
            const int v0 = vb * 32 + 8 * g + 4 * hh;
            const u32x2 gate = gate2[g]; const f32x4 gn = *(const f32x4*)(hg + v0);
            u32x2 w; w.x = pk2(o[4 * g] * rstd * gn.x * bflo(gate.x), o[4 * g + 1] * rstd * gn.y * bfhi(gate.x)); w.y = pk2(o[4 * g + 2] * rstd * gn.z * bflo(gate.y), o[4 * g + 3] * rstd * gn.w * bfhi(gate.y));
            *(u32x2*)(mix + row * D + 512 + h * 128 + v0) = w;
        }
    }
    __syncthreads();
}

struct Params { const float* in[17]; float* out; unsigned char* ws; int ph_lo, ph_hi; };
enum { I_X = 0, I_ATTN_G, I_WIN, I_QG, I_KG, I_LQ1, I_LK1, I_LQ2, I_LK2, I_SUBG, I_LB, I_HG, I_WOUT, I_FFN_G, I_WGATE, I_WUP, I_WDOWN };

__global__ void __launch_bounds__(NTHR, 2) fwd_megakernel(Params p) {
    extern __shared__ __attribute__((aligned(16))) unsigned char lds[];
    cg::grid_group grid = cg::this_grid();
    const int G = gridDim.x, bx = blockIdx.x;
    const int vcu = (G % 8 == 0) ? (bx % 8) * (G / 8) + bx / 8 : bx;
    const int NGW = G * NWAVES;
    unsigned char* ws = p.ws;
    bf16_t* win_t = (bf16_t*)(ws + WS_WIN); bf16_t* wout_t = (bf16_t*)(ws + WS_WOUT); bf16_t* wgu_t = (bf16_t*)(ws + WS_WGU); bf16_t* wdn_t = (bf16_t*)(ws + WS_WDN);
    float* ss = (float*)(ws + WS_SS); bf16_t* xg = (bf16_t*)(ws + WS_XG); bf16_t* Obuf = (bf16_t*)p.out;     bf16_t* proj = (bf16_t*)(ws + WS_PROJ); bf16_t* hbuf = proj; bf16_t* mix = (bf16_t*)(ws + WS_MIX); bf16_t* stbuf = (bf16_t*)(ws + WS_ST); float* dbuf = (float*)ws;
    LAS unsigned char* ldsl = (LAS unsigned char*)lds;
    volatile LAS unsigned* MISC = (volatile LAS unsigned*)(ldsl + MISC_OFF);
    if (threadIdx.x < 4) MISC[threadIdx.x] = 0u;
    __syncthreads();
    XcdBarrier xbar = xcd_barrier_post((unsigned*)(ws + WS_BAR), MISC);

    for (int ph = p.ph_lo; ph < p.ph_hi; ++ph) {
        if (ph % PH_PER_LAYER == 0 && ph > 0) continue;
        if (ph > p.ph_lo) {
            if (p.ph_hi > N_PHASES) grid.sync();
            xcd_barrier(xbar); if (DUPMASK & 256) xcd_barrier(xbar); }
        const int l = ph / PH_PER_LAYER, k = ph % PH_PER_LAYER;
        int tid = threadIdx.x; asm volatile("" : "+v"(tid));
        int Gl = G; asm volatile("" : "+s"(Gl));
        const int lane = tid & 63, wave = __builtin_amdgcn_readfirstlane(tid >> 6), gw = vcu * NWAVES + wave;
        if (k == 0 && (PHMASK & 1)) {
            LAS float* scr = (LAS float*)ldsl;
            for (int rep = 0; rep < NREP(0); ++rep)
            for (int it = bx; it < CV_IN + CV_OUT; it += G) {
                if (it < CV_IN) convert_macro(p.in[I_WIN], p.in[I_ATTN_G], D, DIN, win_t, (it / 14) * 64, (it % 14) * 256, 0, scr, tid);
                else { const int r = it - CV_IN; convert_macro(p.in[I_WOUT], nullptr, D, D, wout_t, (r / 4) * 64, (r % 4) * 256, 0, scr, tid); }
            }
            for (int m = gw * 4; m < M; m += NGW * 4) prologue_rows<4>(p.in[I_X] + (size_t)m * D, xg + (size_t)m * D, ss + (size_t)m * 16, lane);
        } else if (k == 1 && (PHMASK & 2)) {
            const int remA = ((M / 256) * (DIN / 256)) % G, firstA = remA ? remA : 0, nconvA = remA ? G - remA : G;
            const int nmyA = (bx >= firstA) ? (2 * CV_G - (bx - firstA) + nconvA - 1) / nconvA : 0, npreA = nmyA / 2;
            { LAS float* scr = (LAS float*)ldsl;
              for (int j = 0; j < npreA; ++j) {
                  int r = bx - firstA + j * nconvA;
                  if (r < CV_G) { convert_macro(p.in[I_WGATE] + (size_t)l * D * FF, p.in[I_FFN_G] + l * D, D, FF, wgu_t, (r / 11) * 64, (r % 11) * 256, 1, scr, tid); continue; } r -= CV_G;
                  if (r < CV_G) { convert_macro(p.in[I_WUP] + (size_t)l * D * FF, p.in[I_FFN_G] + l * D, D, FF, wgu_t, (r / 11) * 64, (r % 11) * 256, 2, scr, tid); continue; } r -= CV_G;
                  convert_macro(p.in[I_WDOWN] + (size_t)l * FF * D, nullptr, FF, D, wdn_t, (r / 4) * 64, (r % 4) * 256, 0, scr, tid);
              } }
            pg8::Gemm g{xg, win_t, M, DIN, D}; pg8::StaticOrder S; S.init(M, DIN, G, bx);
            if (Gl == 256) {
                pg8::Unit u0; S.next(0, u0); build_row_tables(ldsl, ss, u0.pm, p.in[I_LB], l, tid, p.in[I_QG] + l * 64, p.in[I_KG] + l * 64);
                EpiA<true> E{proj, ss, p.in[I_LB], l, (const LAS float*)(ldsl + RSTD_OFF), (const LAS float*)(ldsl + LBT_OFF), ldsl};
                for (int rep = 0; rep < NREP(1); ++rep) pg8::gemm_phase<EpiA<true>, pg8::StaticOrder, true, true>(ldsl, g, S, E);
            } else {
                EpiA<false> E{proj, ss, p.in[I_LB], l, nullptr, nullptr, nullptr};
                pg8::gemm_phase<EpiA<false>, pg8::StaticOrder, true, true>(ldsl, g, S, E);
            }
            { LAS float* scr = (LAS float*)ldsl;
              for (int j = npreA; j < nmyA; ++j) {
                  int r = bx - firstA + j * nconvA;
                  if (r < CV_G) { convert_macro(p.in[I_WGATE] + (size_t)l * D * FF, p.in[I_FFN_G] + l * D, D, FF, wgu_t, (r / 11) * 64, (r % 11) * 256, 1, scr, tid); continue; } r -= CV_G;
                  if (r < CV_G) { convert_macro(p.in[I_WUP] + (size_t)l * D * FF, p.in[I_FFN_G] + l * D, D, FF, wgu_t, (r / 11) * 64, (r % 11) * 256, 2, scr, tid); continue; } r -= CV_G;
                  convert_macro(p.in[I_WDOWN] + (size_t)l * FF * D, nullptr, FF, D, wdn_t, (r / 4) * 64, (r % 4) * 256, 0, scr, tid);
              } }
        } else if (k == 2 && (PHMASK & 4)) {
#if HGRN_NAIVE
            if (bx < 16) hgrn_naive((LAS float*)ldsl, proj, mix, bx, tid);
            else for (int m = ((bx - 16) * NWAVES + wave) * 4; m < M; m += (G - 16) * NWAVES * 4) qknorm_rows<4>(proj + (size_t)m * DIN, p.in[I_QG] + l * 64, p.in[I_KG] + l * 64, lane);
#else
            if (Gl != 256) for (int m = gw * 8; m < M; m += NGW * 8) qknorm_rows<8>(proj + (size_t)m * DIN, p.in[I_QG] + l * 64, p.in[I_KG] + l * 64, lane);
            for (int rep = 0; rep < NREP(2); ++rep)
            for (int it = vcu; it < 1024; it += G) hgrn_stage1(ldsl, proj, stbuf, dbuf, it, tid);
#endif
        } else if (k == 3 && (PHMASK & 8)) {
            for (int rep = 0; rep < NREP(3); ++rep)
            for (int it = vcu; it < 256; it += G) {
                const int bq = it >> 3, s = it & 7, b = bq >> 3, qh = bq & 7, h = qh >> 1;
                for (int j = 0; j < 2; ++j) {
                    attn_body::attn_unit<8>(b, C_Q + qh * 64, C_K + qh * 64, C_V + h * 128, qh * 128, j ? s : 15 - s, (const attn_body::bf16*)proj, (attn_body::bf16*)Obuf, (char*)lds);
#if !HGRN_NAIVE
                    if (j == 0 && it == vcu) { int t2 = threadIdx.x; asm volatile("" : "+v"(t2));
                        const int wv2 = __builtin_amdgcn_readfirstlane(t2 >> 6);
                        for (int rowid = vcu * NWAVES + wv2; rowid < 16 * 128; rowid += NGW) hgrn_scan_row(stbuf, dbuf, rowid, t2 & 63); }
#endif
                }
            }
#if !HGRN_NAIVE
            if (vcu >= 256) for (int rowid = gw; rowid < 16 * 128; rowid += NGW) hgrn_scan_row(stbuf, dbuf, rowid, lane);
#endif
        } else if (k == 4 && (PHMASK & 16)) {
            const float li = 0.8f - 0.6f * expf(-0.3f * (float)l);
            const float d1 = wave_sum(p.in[I_LQ1][l * 64 + lane] * p.in[I_LK1][l * 64 + lane]), d2 = wave_sum(p.in[I_LQ2][l * 64 + lane] * p.in[I_LK2][l * 64 + lane]);
            const float lam = expf(d1) - expf(d2) + li;
#if !HGRN_NAIVE
            for (int rep = 0; rep < NREP(4); ++rep)
            for (int it = vcu; it < 1024; it += G) hgrn_stage3(ldsl, proj, stbuf, mix, p.in[I_HG] + l * 128, it, tid);
#endif
            for (int rep = 0; rep < NREP(5); ++rep)
            for (int m = gw * 8; m < M; m += NGW * 8) combine_rows<8>(Obuf + (size_t)m * D, mix + (size_t)m * D, p.in[I_SUBG] + l * 128, lam, 1.f - li, lane);
#if HGRN_NAIVE
            for (int m = gw; m < M; m += NGW) hgrn_norm_row(mix + (size_t)m * D, proj + (size_t)m * DIN, p.in[I_HG] + l * 128, lane);
#endif
        } else if (k == 6 && (PHMASK & 64)) {
            if (l + 1 < DEPTH) {
                const int remD = ((M / 256) * (2 * FF / 256)) % G, firstD = remD ? remD : 0, nconvD = remD ? G - remD : G;
                if (bx >= firstD) { LAS float* scr = (LAS float*)ldsl;
                    for (int it = bx - firstD; it < CV_IN + CV_OUT; it += nconvD) {
                        if (it < CV_IN) convert_macro(p.in[I_WIN] + (size_t)(l + 1) * D * DIN, p.in[I_ATTN_G] + (l + 1) * D, D, DIN, win_t, (it / 14) * 64, (it % 14) * 256, 0, scr, tid);
                        else { const int r = it - CV_IN; convert_macro(p.in[I_WOUT] + (size_t)(l + 1) * D * D, nullptr, D, D, wout_t, (r / 4) * 64, (r % 4) * 256, 0, scr, tid); }
                    } }
            }
            pg8::Gemm g{xg, wgu_t, M, 2 * FF, D}; pg8::StaticOrder S; S.init(M, 2 * FF, G, bx);
            if (Gl == 256) {
                pg8::Unit u0; S.next(0, u0); build_row_tables(ldsl, ss, u0.pm, nullptr, 0, tid);
                EpiGU<true> E{hbuf, ss, (const LAS float*)(ldsl + RSTD_OFF)};
                for (int rep = 0; rep < NREP(6); ++rep) pg8::gemm_phase<EpiGU<true>, pg8::StaticOrder, true, true>(ldsl, g, S, E);
            } else {
                EpiGU<false> E{hbuf, ss, nullptr};
                pg8::gemm_phase<EpiGU<false>, pg8::StaticOrder, true, true>(ldsl, g, S, E);
            }
            {
                int bxd = bx; asm volatile("" : "+s"(bxd));
                const int remD2 = ((M / 256) * (2 * FF / 256)) % G, firstD2 = remD2 ? remD2 : 0, nconvD2 = remD2 ? G - remD2 : G;
                if (bxd >= firstD2) { LAS float* scr = (LAS float*)ldsl;
                    for (int r = bxd - firstD2; r < CV_DN; r += nconvD2) convert_macro(p.in[I_WDOWN] + (size_t)l * FF * D, nullptr, FF, D, wdn_t, (r / 4) * 64, (r % 4) * 256, 0, scr, tid); }
            }
        } else if ((k == 5 && (PHMASK & 32)) || (k == 7 && (PHMASK & 128))) {
            const pg8::Gemm g = (k == 5) ? pg8::Gemm{mix, wout_t, M, D, D} : pg8::Gemm{hbuf, wdn_t, M, D, FF};
            pg8::StaticOrder S; S.init(M, D, G, bx);
            if (k == 5 && l == 0) { EpiRes<true, false> E{p.in[I_X], xg, nullptr, ss}; pg8::gemm_phase<EpiRes<true, false>, pg8::StaticOrder, true, true>(ldsl, g, S, E); }
            else if (k == 7 && l + 1 == DEPTH) { EpiRes<false, true> E{nullptr, xg, p.out, ss}; pg8::gemm_phase<EpiRes<false, true>, pg8::StaticOrder, true, true>(ldsl, g, S, E); }
            else { EpiRes<false, false> E{nullptr, xg, nullptr, ss}; pg8::gemm_phase<EpiRes<false, false>, pg8::StaticOrder, true, true>(ldsl, g, S, E); }
        }
    }
}

extern "C" void kernel_launch(void* const* d_in, const int* in_sizes, int n_in, void* d_out, int out_size, void* d_ws, size_t ws_size, hipStream_t stream) {
    static int grid = 0;
    if (grid == 0) {
        if (n_in != 17 || in_sizes[0] != M * D || out_size != M * D || ws_size < WS_END) { fprintf(stderr, "kernel_launch: unexpected shapes (n_in %d, in0 %d, out %d, ws %zu); nothing launched\n", n_in, n_in > 0 ? in_sizes[0] : -1, out_size, ws_size); grid = -1; return; }
        int dev = 0, cus = 0, per_cu = 0;
        hipGetDevice(&dev); hipDeviceGetAttribute(&cus, hipDeviceAttributeMultiprocessorCount, dev);
        if (hipFuncSetAttribute((const void*)fwd_megakernel, hipFuncAttributeMaxDynamicSharedMemorySize, LDS_BYTES) != hipSuccess) { fprintf(stderr, "kernel_launch: hipFuncSetAttribute failed\n"); grid = -1; return; }
        if (hipOccupancyMaxActiveBlocksPerMultiprocessor(&per_cu, (const void*)fwd_megakernel, NTHR, LDS_BYTES) != hipSuccess || per_cu < 1) { fprintf(stderr, "kernel_launch: occupancy query says %d\n", per_cu); per_cu = 1; }
        (void)hipGetLastError();
        grid = cus * per_cu;
    }
    if (grid < 0) return;
    if (hipMemsetAsync((char*)d_ws + WS_BAR, 0, BAR_BYTES, stream) != hipSuccess) { fprintf(stderr, "kernel_launch: memset of the barrier words failed\n"); return; }
    Params p{};
    for (int i = 0; i < 17; ++i) p.in[i] = (const float*)d_in[i];
    p.out = (float*)d_out; p.ws = (unsigned char*)d_ws;
#if MK_PER_PHASE_LAUNCHES
    for (int ph = 0; ph < N_PHASES; ++ph) { p.ph_lo = ph; p.ph_hi = ph + 1; hipLaunchKernelGGL(fwd_megakernel, dim3(grid), dim3(NTHR), LDS_BYTES, stream, p); }
#else
    p.ph_lo = 0; p.ph_hi = N_PHASES;
    void* args[] = {&p};
    hipError_t e = hipLaunchCooperativeKernel((const void*)fwd_megakernel, dim3(grid), dim3(NTHR), args, LDS_BYTES, stream);
    if (e != hipSuccess) fprintf(stderr, "cooperative launch failed: %s (grid %d)\n", hipGetErrorString(e), grid);
#endif
}
```

```cpp
#include <hip/hip_runtime.h>
#include <hip/hip_cooperative_groups.h>
#include <hip/hip_bf16.h>
#include <cstdio>
#include <cstdint>
#include <cmath>
namespace cg = cooperative_groups;
#ifndef MK_PER_PHASE_LAUNCHES
#define MK_PER_PHASE_LAUNCHES 0
#endif
namespace pg8 {
#define PG8_LAS __attribute__((address_space(3)))
typedef unsigned short bf16_t;
typedef short bf16x8 __attribute__((ext_vector_type(8)));
typedef float f32x4 __attribute__((ext_vector_type(4)));
typedef unsigned u32x4 __attribute__((ext_vector_type(4)));
constexpr int BM = 256, BK = 64, HALF = 128, HTB = HALF * BK * 2  , STAGE_BYTES = 8 * HTB, NXCD = 8, WGM = 8;

__host__ __device__ __forceinline__ int lds_byte(int r, int c) { const int st = (r >> 4) * 2 + (c >> 5), rr = r & 15, cc = c & 31, ob = rr * 64 + cc * 2; return st * 1024 + (ob ^ (((ob >> 9) & 1) << 5)); }
__host__ __device__ __forceinline__ void stage_rc(int b, int& R, int& C) { const int st = b / 1024, sb = b % 1024, swz = sb ^ (((sb >> 9) & 1) << 5); R = (st >> 1) * 16 + swz / 64; C = (st & 1) * 32 + (swz % 64) / 2; }
__host__ __device__ __forceinline__ int perm32(int rho) { const int n = rho >> 4, i = rho & 15; return 8 * (i >> 2) + 4 * n + (i & 3); }

struct Unit { int pm, pn; };
struct Gemm { const bf16_t* A; const bf16_t* Bt; int M, N, K; };

struct StaticOrder {
    int nM, nN, nwg, G, c;
    __host__ __device__ void init(int M, int N, int G_, int c_) { nM = M / BM; nN = N / BM; nwg = nM * nN; G = G_; c = c_; }
    __host__ __device__ bool next(int i, Unit& u) const {
        const long L = (long)i * G + c; if (L >= nwg) return false;
        int wgid = (int)L; { const int q = nwg / NXCD, r = nwg % NXCD, xcd = wgid % NXCD, off = wgid / NXCD; wgid = (xcd < r ? xcd * (q + 1) : r * (q + 1) + (xcd - r) * q) + off; }
        const int nig = WGM * nN, gid = wgid / nig, fm = gid * WGM, gsz = (nM - fm) < WGM ? (nM - fm) : WGM;
        u.pm = fm + ((wgid % nig) % gsz); u.pn = (wgid % nig) / gsz; return true;
    }
    __device__ __forceinline__ void a_ready(const Unit&) const {}
    __device__ __forceinline__ void done(const Unit&) const {}
};

__device__ __forceinline__ unsigned cvt_pk_bf16(float lo, float hi) { unsigned r; asm volatile("v_cvt_pk_bf16_f32 %0, %1, %2" : "=v"(r) : "v"(lo), "v"(hi)); return r; }

template <class Epi, class Sched, bool ALIGN_EPI = false, bool SP2 = false>
__device__ __forceinline__ void gemm_phase(PG8_LAS unsigned char* lds, const Gemm g, const Sched& S, const Epi& E) {
    int tid_ = threadIdx.x; asm volatile("" : "+v"(tid_));
    const int tid = tid_, wid = __builtin_amdgcn_readfirstlane(tid >> 6), lane = tid & 63, wr = wid >> 2, wc = wid & 3, fr = lane & 15, fq = lane >> 4;
    const int K = g.K, nt = K / BK;
    unsigned voffA[2], voffB[2];
#pragma unroll
    for (int i = 0; i < 2; ++i) { int R, C; stage_rc(tid * 16 + i * 8192, R, C); const int Rb = Epi::PERM ? ((R & ~31) + perm32(R & 31)) : R;
        voffA[i] = (unsigned)(R * K + C) * 2u; voffB[i] = (unsigned)(Rb * K + C) * 2u; }
    const size_t kstep = (size_t)(BK * 2);
    const size_t hstep = (size_t)HALF * K * 2;
    const size_t tstep = 2 * hstep;
    const unsigned ldsw = (unsigned)wid * 1024u;
    const int aoff = lds_byte(wr * 64 + fr, fq * 8), boff = lds_byte(wc * 32 + fr, fq * 8);
#define PG8_SA(b, h) (((b) * 2 + (h)) * HTB)
#define PG8_SB(b, h) ((4 + (b) * 2 + (h)) * HTB)
#define PG8_STAGE(bufoff, gbase, voff) do { _Pragma("unroll") for (int _i = 0; _i < 2; ++_i) \
        __builtin_amdgcn_global_load_lds((const unsigned*)((const char*)(gbase) + (voff)[_i]), (PG8_LAS unsigned*)(lds + (bufoff) + ldsw + _i * 8192), 16, 0, 0); } while (0)
#define PG8_LDA(dst, b, h) do { _Pragma("unroll") for (int m = 0; m < 4; ++m) _Pragma("unroll") for (int k = 0; k < 2; ++k) dst[m][k] = *(const PG8_LAS bf16x8*)(lds + PG8_SA(b, h) + aoff + m * 2048 + k * 1024); } while (0)
#define PG8_LDB(dst, b, h) do { _Pragma("unroll") for (int n = 0; n < 2; ++n) _Pragma("unroll") for (int k = 0; k < 2; ++k) dst[n][k] = *(const PG8_LAS bf16x8*)(lds + PG8_SB(b, h) + boff + n * 2048 + k * 1024); } while (0)
#define PG8_MMA(ai, bj, At, Bt) do { __builtin_amdgcn_s_setprio(1); _Pragma("unroll") for (int m = 0; m < 4; ++m) _Pragma("unroll") for (int n = 0; n < 2; ++n) _Pragma("unroll") for (int k = 0; k < 2; ++k) \
        acc[ai][bj][m][n] = __builtin_amdgcn_mfma_f32_16x16x32_bf16(Bt[n][k], At[m][k], acc[ai][bj][m][n], 0, 0, 0); __builtin_amdgcn_s_setprio(0); } while (0)
#define PG8_WAIT_V(n) asm volatile("s_waitcnt vmcnt(" #n ")" ::: "memory")
#define PG8_WAIT_L(n) asm volatile("s_waitcnt lgkmcnt(" #n ")" ::: "memory")
#define PG8_BAR __builtin_amdgcn_s_barrier()
#define PG8_SCHED __builtin_amdgcn_sched_barrier(0)
    Unit cur, nxt; int ui = 0;
    if (!S.next(0, cur)) return;
    f32x4 acc[2][2][4][2];
#pragma unroll
    for (int a = 0; a < 2; ++a)
#pragma unroll
        for (int b = 0; b < 2; ++b)
#pragma unroll
            for (int m = 0; m < 4; ++m)
#pragma unroll
                for (int n = 0; n < 2; ++n) acc[a][b][m][n] = (f32x4){0.f, 0.f, 0.f, 0.f};
    bf16x8 At[4][2], B0[2][2], B1[2][2];
    const char* cA = (const char*)g.A + (size_t)cur.pm * tstep; const char* cB = (const char*)g.Bt + (size_t)cur.pn * tstep;
    S.a_ready(cur);
    if constexpr (SP2) {
        PG8_STAGE(PG8_SB(0, 0), cB, voffB); PG8_STAGE(PG8_SB(0, 1), cB + hstep, voffB); PG8_STAGE(PG8_SA(0, 0), cA, voffA); PG8_STAGE(PG8_SA(0, 1), cA + hstep, voffA);
        if (wr == 1) PG8_BAR;
        PG8_WAIT_V(2); PG8_BAR;
        PG8_STAGE(PG8_SB(1, 0), cB + kstep, voffB); PG8_STAGE(PG8_SA(1, 0), cA + kstep, voffA); PG8_STAGE(PG8_SB(1, 1), cB + hstep + kstep, voffB);
        PG8_WAIT_V(6); PG8_BAR;
    } else {
        PG8_STAGE(PG8_SB(0, 0), cB, voffB); PG8_STAGE(PG8_SA(0, 0), cA, voffA); PG8_STAGE(PG8_SB(0, 1), cB + hstep, voffB); PG8_STAGE(PG8_SA(0, 1), cA + hstep, voffA);
        if (wr == 1) PG8_BAR;
        PG8_WAIT_V(4); PG8_BAR;
        PG8_STAGE(PG8_SB(1, 0), cB + kstep, voffB); PG8_STAGE(PG8_SA(1, 0), cA + kstep, voffA); PG8_STAGE(PG8_SB(1, 1), cB + hstep + kstep, voffB);
        PG8_WAIT_V(6); PG8_BAR;
    }
    for (;;) {
        const bool has_next = S.next(ui + 1, nxt);
        const char* nA = has_next ? (const char*)g.A + (size_t)nxt.pm * tstep : cA; const char* nB = has_next ? (const char*)g.Bt + (size_t)nxt.pn * tstep : cB;
        for (int t = 0; t < nt; t += 2) {
            const bool last = (t == nt - 2);
            const char* a1 = cA + (size_t)(t + 1) * kstep;
            const char* a2 = last ? nA : cA + (size_t)(t + 2) * kstep; const char* b2 = last ? nB : cB + (size_t)(t + 2) * kstep;
            const char* a3 = a2 + kstep; const char* b3 = b2 + kstep;
            if (last && has_next) S.a_ready(nxt);
            if constexpr (SP2) {
            PG8_LDB(B0, 0, 0); PG8_LDB(B1, 0, 1); PG8_SCHED; PG8_LDA(At, 0, 0); PG8_STAGE(PG8_SA(1, 1), a1 + hstep, voffA);
            PG8_WAIT_V(8); PG8_WAIT_L(0); PG8_BAR; PG8_MMA(0, 0, At, B0); PG8_MMA(0, 1, At, B1); PG8_BAR; PG8_SCHED;
            PG8_LDA(At, 0, 1); PG8_STAGE(PG8_SB(0, 0), b2, voffB); PG8_STAGE(PG8_SB(0, 1), b2 + hstep, voffB); PG8_STAGE(PG8_SA(0, 0), a2, voffA);
            PG8_WAIT_V(8); PG8_WAIT_L(0); PG8_BAR; PG8_MMA(1, 0, At, B0); PG8_MMA(1, 1, At, B1); PG8_BAR; PG8_SCHED;
            PG8_LDB(B0, 1, 0); PG8_LDB(B1, 1, 1); PG8_SCHED; PG8_LDA(At, 1, 0); PG8_STAGE(PG8_SA(0, 1), a2 + hstep, voffA);
            PG8_WAIT_V(8); PG8_WAIT_L(0); PG8_BAR; PG8_MMA(0, 0, At, B0); PG8_MMA(0, 1, At, B1); PG8_BAR; PG8_SCHED;
            PG8_LDA(At, 1, 1); PG8_STAGE(PG8_SB(1, 0), b3, voffB); PG8_STAGE(PG8_SB(1, 1), b3 + hstep, voffB); PG8_STAGE(PG8_SA(1, 0), a3, voffA);
            PG8_WAIT_V(8); PG8_WAIT_L(0); PG8_BAR; PG8_MMA(1, 0, At, B0); PG8_MMA(1, 1, At, B1); PG8_BAR; PG8_SCHED;
            } else {
            PG8_LDB(B0, 0, 0); PG8_SCHED; PG8_LDA(At, 0, 0); PG8_STAGE(PG8_SA(1, 1), a1 + hstep, voffA);
            PG8_WAIT_L(8); PG8_BAR; PG8_WAIT_L(0); PG8_MMA(0, 0, At, B0); PG8_BAR; PG8_SCHED;
            PG8_LDB(B1, 0, 1); PG8_STAGE(PG8_SB(0, 0), b2, voffB);
            PG8_BAR; PG8_WAIT_L(0); PG8_MMA(0, 1, At, B1); PG8_BAR;
            PG8_LDA(At, 0, 1); PG8_STAGE(PG8_SA(0, 0), a2, voffA);
            PG8_BAR; PG8_WAIT_L(0); PG8_MMA(1, 0, At, B0); PG8_BAR; PG8_SCHED;
            PG8_STAGE(PG8_SB(0, 1), b2 + hstep, voffB);
            PG8_WAIT_V(6); PG8_BAR; PG8_MMA(1, 1, At, B1); PG8_BAR;
            PG8_LDB(B0, 1, 0); PG8_SCHED; PG8_LDA(At, 1, 0); PG8_STAGE(PG8_SA(0, 1), a2 + hstep, voffA);
            PG8_WAIT_L(8); PG8_BAR; PG8_WAIT_L(0); PG8_MMA(0, 0, At, B0); PG8_BAR; PG8_SCHED;
            PG8_LDB(B1, 1, 1); PG8_STAGE(PG8_SB(1, 0), b3, voffB);
            PG8_BAR; PG8_WAIT_L(0); PG8_MMA(0, 1, At, B1); PG8_BAR;
            PG8_LDA(At, 1, 1); PG8_STAGE(PG8_SA(1, 0), a3, voffA);
            PG8_BAR; PG8_WAIT_L(0); PG8_MMA(1, 0, At, B0); PG8_BAR; PG8_SCHED;
            PG8_STAGE(PG8_SB(1, 1), b3 + hstep, voffB);
            PG8_WAIT_V(6); PG8_BAR; PG8_MMA(1, 1, At, B1); PG8_BAR;
            }
        }
        if constexpr (ALIGN_EPI) { if (wr == 0) PG8_BAR; }
        if constexpr (!Epi::AFTER_DRAIN) { E(acc, cur, wr, wc, fr, fq); S.done(cur); }
        if (!has_next) break;
#pragma unroll
        for (int a = 0; a < 2; ++a)
#pragma unroll
            for (int b = 0; b < 2; ++b)
#pragma unroll
                for (int m = 0; m < 4; ++m)
#pragma unroll
                    for (int n = 0; n < 2; ++n) acc[a][b][m][n] = (f32x4){0.f, 0.f, 0.f, 0.f};
        cur = nxt; cA = nA; cB = nB; ++ui;
        if constexpr (ALIGN_EPI) { if (wr == 1) PG8_BAR; }
    }
    PG8_WAIT_V(0);
    if constexpr (!ALIGN_EPI) { if (wr == 0) PG8_BAR; }
    PG8_BAR;
    if constexpr (Epi::AFTER_DRAIN) { E.fused(acc, cur, wr, wc, fr, fq, lds, wid, lane); S.done(cur); }
#undef PG8_SA
#undef PG8_SB
#undef PG8_STAGE
#undef PG8_LDA
#undef PG8_LDB
#undef PG8_MMA
#undef PG8_WAIT_V
#undef PG8_WAIT_L
#undef PG8_BAR
#undef PG8_SCHED
}
}
#ifndef PG8_SP2
#define PG8_SP2 true
#endif
namespace attn_body {
using bf16=__hip_bfloat16;
using bf16x8=__attribute__((ext_vector_type(8)))short;
using s16x4=__attribute__((ext_vector_type(4)))short;
using f32x16=__attribute__((ext_vector_type(16)))float;
using u32x4=__attribute__((ext_vector_type(4)))unsigned;
constexpr int BATCH=4,SEQ=4096,D=64,PQ=3584,PO=1024;
constexpr int NW=8,QBLK=32,QB=QBLK*NW,KVBLK=64,NQB=SEQ/QB;
constexpr int ATTN_UNIT_ROWS=QB;
__device__ __forceinline__ int crow(int r,int hi){return (r&3)+8*(r>>2)+4*hi;}
#define SBAR() __builtin_amdgcn_sched_barrier(0)
__device__ __forceinline__ void cmask(f32x16&p0,f32x16&p1,int jb,int wid){
  const float NEG=-INFINITY;
  if(jb>(wid>>1)){
    #pragma unroll
    for(int r=0;r<16;++r){p0[r]=NEG;p1[r]=NEG;}}
}

constexpr int NSLOT=3, SLOTB=8192;
constexpr int LDS_K=0, LDS_V=NSLOT*SLOTB, LDS_WS=3*NSLOT*SLOTB, LDS_OST=LDS_WS+NW*64*4, LDS_BYTES=LDS_OST+NW*4096;
constexpr float C2=0.125f*1.4426950408889634f;
__device__ __forceinline__ void glds16(const void*gsrc,unsigned lds_dst){unsigned keep;
  asm volatile("s_mov_b32 %0, m0\n\ts_mov_b32 m0, %2\n\ts_nop 0\n\tglobal_load_lds_dwordx4 %1, off\n\ts_mov_b32 m0, %0":"=&s"(keep):"v"(gsrc),"s"(lds_dst):"memory");}
__device__ __forceinline__ float max3f(float a,float b,float c){float r;asm("v_max3_f32 %0, %1, %2, %3":"=v"(r):"v"(a),"v"(b),"v"(c));return r;}
__device__ __forceinline__ float max2f(float a,float b){float r;asm("v_max_f32_e32 %0, %1, %2":"=v"(r):"v"(a),"v"(b));return r;}
__device__ __forceinline__ float fadd_s(float a,float b){float r;asm("v_add_f32_e32 %0, %1, %2":"=v"(r):"v"(a),"v"(b));return r;}
__device__ __forceinline__ float fsub_s(float a,float b){float r;asm("v_sub_f32_e32 %0, %1, %2":"=v"(r):"v"(a),"v"(b));return r;}
typedef float f32x2_t __attribute__((ext_vector_type(2))); typedef __bf16 bf16x2_t __attribute__((ext_vector_type(2)));
__device__ __forceinline__ unsigned cvtpk_s(float lo,float hi){f32x2_t v={lo,hi};bf16x2_t b=__builtin_convertvector(v,bf16x2_t);return __builtin_bit_cast(unsigned,b);}
#define WAIT_BAR(N) asm volatile("s_waitcnt vmcnt(" #N ") lgkmcnt(0)\n\ts_barrier":::"memory")

__device__ __forceinline__ void qkt(f32x16&p0,f32x16&p1,const char*Kslot,const bf16x8*qr,const f32x16&negm,int r32,int hi){
  const char*kb=Kslot+hi*1024+r32*16;
  #pragma unroll
  for(int d0=0;d0<4;++d0){
    const bf16x8 b0=*reinterpret_cast<const bf16x8*>(kb+d0*2048);
    const bf16x8 b1=*reinterpret_cast<const bf16x8*>(kb+d0*2048+512);
    if(d0==0){p0=__builtin_amdgcn_mfma_f32_32x32x16_bf16(b0,qr[0],negm,0,0,0);p1=__builtin_amdgcn_mfma_f32_32x32x16_bf16(b1,qr[0],negm,0,0,0);}
    else{p0=__builtin_amdgcn_mfma_f32_32x32x16_bf16(b0,qr[d0],p0,0,0,0);p1=__builtin_amdgcn_mfma_f32_32x32x16_bf16(b1,qr[d0],p1,0,0,0);}}
}
typedef __attribute__((address_space(3))) const char* lds_cptr;
typedef short v4i16_t __attribute__((ext_vector_type(4)));
__device__ __forceinline__ void kload8(bf16x8*kf,lds_cptr kp){
  kf[0]=*(const __attribute__((address_space(3))) bf16x8*)(kp);      kf[1]=*(const __attribute__((address_space(3))) bf16x8*)(kp+512);
  kf[2]=*(const __attribute__((address_space(3))) bf16x8*)(kp+2048); kf[3]=*(const __attribute__((address_space(3))) bf16x8*)(kp+2560);
  kf[4]=*(const __attribute__((address_space(3))) bf16x8*)(kp+4096); kf[5]=*(const __attribute__((address_space(3))) bf16x8*)(kp+4608);
  kf[6]=*(const __attribute__((address_space(3))) bf16x8*)(kp+6144); kf[7]=*(const __attribute__((address_space(3))) bf16x8*)(kp+6656);
}
__device__ __forceinline__ void kload2(bf16x8*kf,lds_cptr kp,int j){ kf[2*j]=*(const __attribute__((address_space(3))) bf16x8*)(kp+j*2048); kf[2*j+1]=*(const __attribute__((address_space(3))) bf16x8*)(kp+j*2048+512); }
__device__ __forceinline__ s16x4 vtr(lds_cptr p){ return __builtin_bit_cast(s16x4,__builtin_amdgcn_ds_read_tr16_b64_v4i16((__attribute__((address_space(3))) v4i16_t*)p)); }
__device__ __forceinline__ float rowmax(const f32x16&p0,const f32x16&p1){
  float a=max3f(p0[0],p0[1],p1[0]),b=max3f(p0[2],p0[3],p1[1]);a=max3f(a,p1[2],p1[3]);
  #pragma unroll
  for(int r=4;r<16;r+=4){a=max3f(a,p0[r],p0[r+1]);b=max3f(b,p0[r+2],p0[r+3]);a=max3f(a,p1[r],p1[r+1]);b=max3f(b,p1[r+2],p1[r+3]);}
  const float m=max2f(a,b);
  auto rr=__builtin_amdgcn_permlane32_swap(__float_as_uint(m),__float_as_uint(m),false,false);
  return max2f(__uint_as_float(rr[0]),__uint_as_float(rr[1]));
}
__device__ __forceinline__ void pv(f32x16*o,int vb,bf16x8 pa0,bf16x8 pa1,bf16x8 pa2,bf16x8 pa3){
  #pragma unroll
  for(int d0=0;d0<2;++d0){s16x4 lo[4],hi[4];
    #pragma unroll
    for(int ks=0;ks<4;++ks){
      asm volatile("ds_read_b64_tr_b16 %0,%1 offset:%c2":"=&v"(lo[ks]):"v"(vb),"i"(d0*4096+ks*1024):"memory");
      asm volatile("ds_read_b64_tr_b16 %0,%1 offset:%c2":"=&v"(hi[ks]):"v"(vb),"i"(d0*4096+ks*1024+512):"memory");}
    asm volatile("s_waitcnt lgkmcnt(0)":::"memory");SBAR();
    #define PK(k) (bf16x8){lo[k][0],lo[k][1],lo[k][2],lo[k][3],hi[k][0],hi[k][1],hi[k][2],hi[k][3]}
    o[d0]=__builtin_amdgcn_mfma_f32_32x32x16_bf16(pa0,PK(0),o[d0],0,0,0);
    o[d0]=__builtin_amdgcn_mfma_f32_32x32x16_bf16(pa1,PK(1),o[d0],0,0,0);
    o[d0]=__builtin_amdgcn_mfma_f32_32x32x16_bf16(pa2,PK(2),o[d0],0,0,0);
    o[d0]=__builtin_amdgcn_mfma_f32_32x32x16_bf16(pa3,PK(3),o[d0],0,0,0);
    #undef PK
  }
}

#ifndef ATTN_STORE16
#define ATTN_STORE16(p,v) (*(u32x4*)(p)=(v))
#endif
template<int THRL> __device__ __forceinline__ void attn_unit(int b,int qcol,int kcol,int vcol,int ocol,int qb,const bf16*__restrict__ P,bf16*O,char*shm){
  int tid_=threadIdx.x; asm volatile("":"+v"(tid_)); const int tid=tid_,lane=tid&63,r32=lane&31,hi=lane>>5; const int wid=__builtin_amdgcn_readfirstlane(tid>>6);
  const long rowbase=(long)b*SEQ; const int q0=qb*QB;
  const bf16*Qw=P+(rowbase+q0+wid*QBLK)*PQ+qcol;
  const bf16*Kh=P+rowbase*PQ+kcol,*Vh=P+rowbase*PQ+vcol;
  const unsigned lds0=(unsigned)(uintptr_t)shm;
  float*wsf=(float*)(shm+LDS_WS)+wid*64;
  const bf16*ksrc=Kh+(long)lane*PQ+wid*8;
  const bf16*vsrc=Vh+(long)(16*(wid&3)+(lane>>2))*PQ+(wid>>2)*32+(lane&3)*8;
  const unsigned kdst=lds0+LDS_K+wid*1024, vdst=lds0+LDS_V+wid*1024;
  #define DMA_K(t,slot) glds16(ksrc+(long)(t)*KVBLK*PQ,(unsigned)__builtin_amdgcn_readfirstlane(kdst+(slot)))
  #define DMA_V(t,slot) do{ glds16(vsrc+(long)(t)*KVBLK*PQ,(unsigned)__builtin_amdgcn_readfirstlane(vdst+2*(slot))); glds16(vsrc+(long)(t)*KVBLK*PQ+64,(unsigned)__builtin_amdgcn_readfirstlane(vdst+2*(slot)+8192)); }while(0)
  const int vb0=(int)(lds0+LDS_V)+((lane>>4)&1)*32+(lane&3)*8+(4*hi+((lane&15)>>2))*64;
  const char*Kbase=shm+LDS_K; bf16x8 kf[8];
  const lds_cptr shm3=(lds_cptr)shm; const lds_cptr kp0=shm3+LDS_K+hi*1024+r32*16; const lds_cptr vp0=shm3+LDS_V+((lane>>4)&1)*32+(lane&3)*8+(4*hi+((lane&15)>>2))*64;
  const int NT=(q0+QB)/KVBLK;
  DMA_K(0,0);DMA_V(0,0);DMA_K(1,SLOTB);
  bf16x8 qr[4];
  #pragma unroll
  for(int d0=0;d0<4;++d0)qr[d0]=*reinterpret_cast<const bf16x8*>(&Qw[(long)r32*PQ+d0*16+hi*8]);
  float mhat=0.f,l_reg=0.f;f32x16 o[4];o[0]=f32x16{};o[1]=f32x16{};o[2]=f32x16{};o[3]=f32x16{};f32x16 negm=f32x16{};asm volatile("":"+v"(negm));
  const int qrel=wid*QBLK+r32;
  #define CMASK(P0,P1,t) do{int jb_=(t)-(NT-4); if(jb_>=0)cmask(P0,P1,jb_,wid);}while(0)
  bool resc=false;
  #define START(P0,P1) do{ const float rm=rowmax(P0,P1); resc=false; \
    { const float dl=rm; mhat=fadd_s(mhat,dl); \
      _Pragma("unroll") for(int r=0;r<16;++r){P0[r]=fsub_s(P0[r],dl);P1[r]=fsub_s(P1[r],dl);} \
      _Pragma("unroll") for(int r=0;r<16;++r)negm[r]=-mhat; asm volatile("":"+v"(negm)); } \
    _Pragma("unroll") for(int r=0;r<16;++r)P0[r]=__builtin_amdgcn_exp2f(P0[r]); }while(0)
  #define RESC() do{ if(resc){ asm volatile("s_waitcnt lgkmcnt(0)":::"memory"); \
      _Pragma("unroll") for(int d_=0;d_<4;++d_) _Pragma("unroll") for(int r=0;r<16;++r)o[d_][r]*=wsf[crow(r,hi)]; } }while(0)
  f32x16 pA0,pA1,pB0,pB1;
  int sl_prev=0,sl_cur=0,sl_next=SLOTB;
  #define ROT() do{sl_prev=sl_cur;sl_cur=sl_next;sl_next=(sl_next==(NSLOT-1)*SLOTB)?0:sl_next+SLOTB;}while(0)
  DMA_K(2,2*SLOTB);
  WAIT_BAR(3);
  qkt(pA0,pA1,Kbase,qr,negm,r32,hi);asm volatile("s_nop 15\n\ts_nop 7":"+v"(pA0),"+v"(pA1));CMASK(pA0,pA1,0);
  START(pA0,pA1);
  _Pragma("unroll") for(int r=0;r<16;++r)pA1[r]=__builtin_amdgcn_exp2f(pA1[r]);
  WAIT_BAR(0);
  DMA_K(3,0);DMA_V(1,SLOTB);
  ROT();
  kload8(kf,kp0+sl_cur);
  WAIT_BAR(3);
  s16x4 vlo[8],vhi[8]; u32x4 pw0,pw1,pw2,pw3;
  #define PKW(P,B) cvtpk_s(P[B],P[B+1])
  #define PAF(k) __builtin_bit_cast(bf16x8,pw##k)
  #define VFR(i) (bf16x8){vlo[i][0],vlo[i][1],vlo[i][2],vlo[i][3],vhi[i][0],vhi[i][1],vhi[i][2],vhi[i][3]}
  #define PIN(x) asm volatile("":"+v"(x))
  #define MX3(a,b,c) __builtin_fmaxf(__builtin_fmaxf((a),(b)),(c))
  #define GAPA(MF,A0,A1,A2,A3,W0,W1,PW) do{ MF; sacc+=A0; sacc+=A1; sacc+=A2; sacc+=A3; PIN(sacc); W0; W1; PIN(PW); SBAR(); }while(0)
  #define EX(v) __builtin_amdgcn_exp2f(v)
  #define GAPB(MF,X,B) do{ MF; X[B]=EX(X[B]); X[B+1]=EX(X[B+1]); PIN(X); SBAR(); }while(0)
  #define GAPB2(MF,X,B,i) do{ MF; VRD2(i); X[B]=EX(X[B]); X[B+1]=EX(X[B+1]); PIN(X); SBAR(); }while(0)
  #define VRD(i) do{ vlo[i]=vtr(vp_+(((i)>>2)*4096+((i)&3)*1024)); vhi[i]=vtr(vp_+(((i)>>2)*4096+((i)&3)*1024+512)); }while(0)
  #define VRD2(i) do{ vlo[i]=vtr(vp_+(8192+((i)>>2)*4096+((i)&3)*1024)); vhi[i]=vtr(vp_+(8192+((i)>>2)*4096+((i)&3)*1024+512)); }while(0)
  #define KRD(G,j) do{ if(G){ kload2(kf,kp0+sl_next,j); SBAR(); } }while(0)
  #define STEP(C0,C1,P0,P1,t,GK,GV,GL) do{ SBAR(); \
    const lds_cptr vp_=vp0+2*sl_prev; \
    VRD(0); SBAR(); float sacc=(P0[0]+P0[1]); \
    GAPA(C0=__builtin_amdgcn_mfma_f32_32x32x16_bf16(kf[0],qr[0],negm,0,0,0), P0[2],P0[3],P0[4],P0[5],     pw0[0]=PKW(P0,0), pw0[1]=PKW(P0,2), pw0); \
    VRD(4); SBAR(); GAPA(C1=__builtin_amdgcn_mfma_f32_32x32x16_bf16(kf[1],qr[0],negm,0,0,0), P0[6],P0[7],P0[8],P0[9],     pw0[2]=PKW(P0,4), pw0[3]=PKW(P0,6), pw0); \
    VRD(1); SBAR(); GAPA(C0=__builtin_amdgcn_mfma_f32_32x32x16_bf16(kf[2],qr[1],C0,0,0,0),   P0[10],P0[11],P0[12],P0[13], pw1[0]=PKW(P0,8), pw1[1]=PKW(P0,10), pw1); \
    VRD(5); SBAR(); GAPA(C1=__builtin_amdgcn_mfma_f32_32x32x16_bf16(kf[3],qr[1],C1,0,0,0),   P0[14],P0[15],P1[0],P1[1],   pw1[2]=PKW(P0,12),pw1[3]=PKW(P0,14), pw1); \
    VRD(2); SBAR(); GAPA(C0=__builtin_amdgcn_mfma_f32_32x32x16_bf16(kf[4],qr[2],C0,0,0,0),   P1[2],P1[3],P1[4],P1[5],     pw2[0]=PKW(P1,0), pw2[1]=PKW(P1,2), pw2); \
    VRD(6); SBAR(); GAPA(C1=__builtin_amdgcn_mfma_f32_32x32x16_bf16(kf[5],qr[2],C1,0,0,0),   P1[6],P1[7],P1[8],P1[9],     pw2[2]=PKW(P1,4), pw2[3]=PKW(P1,6), pw2); \
    VRD(3); SBAR(); GAPA(C0=__builtin_amdgcn_mfma_f32_32x32x16_bf16(kf[6],qr[3],C0,0,0,0),   P1[10],P1[11],P1[12],P1[13], pw3[0]=PKW(P1,8), pw3[1]=PKW(P1,10), pw3); \
    VRD(7); SBAR(); GAPA(C1=__builtin_amdgcn_mfma_f32_32x32x16_bf16(kf[7],qr[3],C1,0,0,0),   P1[14],P1[15],0.f,0.f,       pw3[2]=PKW(P1,12),pw3[3]=PKW(P1,14), pw3); \
    l_reg+=sacc; \
    if(GK){DMA_K((t)+3,sl_cur);} if(GV){DMA_V((t)+1,sl_next);} \
    CMASK(C0,C1,t); \
    { float a=MX3(C0[0],C0[1],C1[0]),b=MX3(C0[2],C0[3],C1[1]); a=MX3(a,C1[2],C1[3]); \
      _Pragma("unroll") for(int r=4;r<16;r+=4){a=MX3(a,C0[r],C0[r+1]);b=MX3(b,C0[r+2],C0[r+3]);a=MX3(a,C1[r],C1[r+1]);b=MX3(b,C1[r+2],C1[r+3]);} \
      float rm=__builtin_fmaxf(a,b); { auto rr=__builtin_amdgcn_permlane32_swap(__float_as_uint(rm),__float_as_uint(rm),false,false); rm=__builtin_fmaxf(__uint_as_float(rr[0]),__uint_as_float(rr[1])); } \
      resc=false; \
      if(__builtin_expect(__any(rm>(float)THRL),0)){ const float dl=__builtin_fmaxf(rm,0.f); mhat+=dl; \
        _Pragma("unroll") for(int r=0;r<16;++r){C0[r]-=dl;C1[r]-=dl;} \
        _Pragma("unroll") for(int r=0;r<16;++r)negm[r]=-mhat; asm volatile("":"+v"(negm)); \
        const float f=__builtin_amdgcn_exp2f(-dl); l_reg*=f; if(hi==0)wsf[r32]=f; resc=true; } } \
    SBAR(); \
    GAPB(o[0]=__builtin_amdgcn_mfma_f32_32x32x16_bf16(PAF(0),VFR(0),o[0],0,0,0), C0,0); \
    GAPB(o[1]=__builtin_amdgcn_mfma_f32_32x32x16_bf16(PAF(0),VFR(4),o[1],0,0,0), C0,2); \
    KRD(GL,0); GAPB(o[0]=__builtin_amdgcn_mfma_f32_32x32x16_bf16(PAF(1),VFR(1),o[0],0,0,0), C0,4); \
    KRD(GL,1); GAPB(o[1]=__builtin_amdgcn_mfma_f32_32x32x16_bf16(PAF(1),VFR(5),o[1],0,0,0), C0,6); \
    KRD(GL,2); GAPB2(o[0]=__builtin_amdgcn_mfma_f32_32x32x16_bf16(PAF(2),VFR(2),o[0],0,0,0), C0,8,0); \
    KRD(GL,3); GAPB2(o[1]=__builtin_amdgcn_mfma_f32_32x32x16_bf16(PAF(2),VFR(6),o[1],0,0,0), C0,10,4); \
    GAPB2(o[0]=__builtin_amdgcn_mfma_f32_32x32x16_bf16(PAF(3),VFR(3),o[0],0,0,0), C0,12,1); \
    GAPB2(o[1]=__builtin_amdgcn_mfma_f32_32x32x16_bf16(PAF(3),VFR(7),o[1],0,0,0), C0,14,5); \
      \
      \
    VRD2(2); VRD2(6); VRD2(3); VRD2(7); SBAR(); \
    GAPB(o[2]=__builtin_amdgcn_mfma_f32_32x32x16_bf16(PAF(0),VFR(0),o[2],0,0,0), C1,0); \
    GAPB(o[3]=__builtin_amdgcn_mfma_f32_32x32x16_bf16(PAF(0),VFR(4),o[3],0,0,0), C1,2); \
    GAPB(o[2]=__builtin_amdgcn_mfma_f32_32x32x16_bf16(PAF(1),VFR(1),o[2],0,0,0), C1,4); \
    GAPB(o[3]=__builtin_amdgcn_mfma_f32_32x32x16_bf16(PAF(1),VFR(5),o[3],0,0,0), C1,6); \
    GAPB(o[2]=__builtin_amdgcn_mfma_f32_32x32x16_bf16(PAF(2),VFR(2),o[2],0,0,0), C1,8); \
    GAPB(o[3]=__builtin_amdgcn_mfma_f32_32x32x16_bf16(PAF(2),VFR(6),o[3],0,0,0), C1,10); \
    GAPB(o[2]=__builtin_amdgcn_mfma_f32_32x32x16_bf16(PAF(3),VFR(3),o[2],0,0,0), C1,12); \
    GAPB(o[3]=__builtin_amdgcn_mfma_f32_32x32x16_bf16(PAF(3),VFR(7),o[3],0,0,0), C1,14); \
    }while(0)
  int t=1;
  #undef CMASK
  #define CMASK(P0,P1,t) do{}while(0)
  for(;t+5<NT;t+=2){
    STEP(pB0,pB1,pA0,pA1,t,true,true,true);     WAIT_BAR(3); RESC(); ROT();
    STEP(pA0,pA1,pB0,pB1,t+1,true,true,true);   WAIT_BAR(3); RESC(); ROT();
  }
  #undef CMASK
  #define CMASK(P0,P1,t) do{int jb_=(t)-(NT-4); if(jb_>=0)cmask(P0,P1,jb_,wid);}while(0)
  #define ENDW(tt) do{ if((tt)+3<NT){WAIT_BAR(3);} else if((tt)+2<NT){WAIT_BAR(2);} else {WAIT_BAR(0);} }while(0)
  for(;t+1<NT;t+=2){
    STEP(pB0,pB1,pA0,pA1,t,(t+3<NT),(t+1<NT),(t+1<NT));       ENDW(t);   RESC(); ROT();
    STEP(pA0,pA1,pB0,pB1,t+1,(t+4<NT),(t+2<NT),(t+2<NT));     ENDW(t+1); RESC(); ROT();
  }
  STEP(pB0,pB1,pA0,pA1,NT-1,false,false,false); RESC();
  { float sacc=pB0[0]+pB0[1]; _Pragma("unroll") for(int r=2;r<16;++r)sacc+=pB0[r]; _Pragma("unroll") for(int r=0;r<16;++r)sacc+=pB1[r]; l_reg+=sacc;
    pw0=(u32x4){PKW(pB0,0),PKW(pB0,2),PKW(pB0,4),PKW(pB0,6)};pw1=(u32x4){PKW(pB0,8),PKW(pB0,10),PKW(pB0,12),PKW(pB0,14)};pw2=(u32x4){PKW(pB1,0),PKW(pB1,2),PKW(pB1,4),PKW(pB1,6)};pw3=(u32x4){PKW(pB1,8),PKW(pB1,10),PKW(pB1,12),PKW(pB1,14)};
    SBAR(); pv(o,vb0+2*sl_cur,PAF(0),PAF(1),PAF(2),PAF(3)); pv(o+2,vb0+2*sl_cur+8192,PAF(0),PAF(1),PAF(2),PAF(3)); }
  #undef PKW
  #undef PAF
  #undef VFR
  #undef PIN
  #undef MX3
  #undef GAPA
  #undef GAPB
  #undef GAPB2
  #undef EX
  #undef VRD
  #undef VRD2
  #undef KRD
  #undef STEP
  #undef ENDW
  {auto rr=__builtin_amdgcn_permlane32_swap(__float_as_uint(l_reg),__float_as_uint(l_reg),false,false);l_reg=__uint_as_float(rr[0])+__uint_as_float(rr[1]);}
  if(hi==0)wsf[32+r32]=l_reg;asm volatile("s_waitcnt lgkmcnt(0)":::"memory");
  float rli[16];
  #pragma unroll
  for(int r=0;r<16;++r)rli[r]=__builtin_amdgcn_rcpf(wsf[32+crow(r,hi)]);
  bf16*Ow=O+(rowbase+q0+wid*QBLK)*PO+ocol;
  { bf16*stg=(bf16*)(shm+LDS_OST)+wid*2048;
    #pragma unroll
    for(int hf=0;hf<2;++hf){
      #pragma unroll
      for(int r=0;r<16;++r){const int orow=crow(r,hi);
        #pragma unroll
        for(int d0=0;d0<2;++d0)stg[orow*64+d0*32+r32]=__float2bfloat16(o[2*hf+d0][r]*rli[r]);}
      asm volatile("s_waitcnt lgkmcnt(0)":::"memory");
      #pragma unroll
      for(int i=0;i<4;++i){const int row=i*8+(lane>>3),ch=lane&7; const u32x4 v=*(const u32x4*)(stg+row*64+ch*8); ATTN_STORE16(Ow+(long)row*PO+hf*64+ch*8,v);}
      asm volatile("s_waitcnt lgkmcnt(0)":::"memory"); } }
  asm volatile("s_waitcnt lgkmcnt(0)\n\ts_barrier":::"memory");
  #undef DMA_K
  #undef DMA_V
  #undef CMASK
  #undef START
  #undef RESC
  #undef ROT
}
constexpr int ATTN_LDS_BYTES=LDS_BYTES;
#undef SBAR
#undef WAIT_BAR
}
#define LAS __attribute__((address_space(3)))
typedef unsigned short bf16_t;
typedef float f32x4 __attribute__((ext_vector_type(4)));
typedef unsigned u32x4 __attribute__((ext_vector_type(4)));
typedef unsigned u32x2 __attribute__((ext_vector_type(2)));

constexpr int NB = 4, SEQ = 4096, M = NB * SEQ, D = 1024, DIN = 3584, FF = 2816, DEPTH = 4;
constexpr int C_Q = 0, C_K = 512, C_V = 1024, C_HQ = 1536, C_F = 2048, C_I = 2560, C_G = 3072;
constexpr size_t MiB = 1u << 20;
constexpr size_t WS_WIN = 1 * MiB, WS_WOUT = 8 * MiB, WS_WGU = 10 * MiB, WS_WDN = 21 * MiB, WS_SS = 27 * MiB, WS_XG = 28 * MiB, WS_PROJ = 60 * MiB, WS_MIX = 172 * MiB, WS_ST = 204 * MiB, WS_END = 236 * MiB;
constexpr int NWAVES = 8, NTHR = 512, LDS_BYTES = 147456, MISC_OFF = 139264;
constexpr size_t WS_BAR = 768 * 1024, BAR_BYTES = 16384;
constexpr float NORM_EPS = 1e-6f, LOG2E = 1.4426950408889634f;
#ifndef HGRN_NAIVE
#define HGRN_NAIVE 0
#endif
#ifndef DUPMASK
#define DUPMASK 0
#endif
#define NREP(k) (((DUPMASK >> (k)) & 1) ? 2 : 1)
#ifndef PHMASK
#define PHMASK 255
#endif
constexpr int PH_PER_LAYER = 8, N_PHASES = DEPTH * PH_PER_LAYER;

__device__ __forceinline__ unsigned f2bf(float f) { unsigned u = __builtin_bit_cast(unsigned, f); return (u + 0x7fffu + ((u >> 16) & 1u)) >> 16; }
__device__ __forceinline__ unsigned pk2(float lo, float hi) { return f2bf(lo) | (f2bf(hi) << 16); }
__device__ __forceinline__ float bf2f(bf16_t b) { return __builtin_bit_cast(float, (unsigned)b << 16); }
__device__ __forceinline__ float bflo(unsigned w) { return __builtin_bit_cast(float, w << 16); }
__device__ __forceinline__ float bfhi(unsigned w) { return __builtin_bit_cast(float, w & 0xffff0000u); }
__device__ __forceinline__ float wave_sum(float v) {
#pragma unroll
    for (int o = 1; o < 64; o <<= 1) v += __shfl_xor(v, o);
    return v;
}
__device__ __forceinline__ float sigmoid_f(float v) { return __builtin_amdgcn_rcpf(1.f + __expf(-v)); }
__device__ __forceinline__ float silu_f(float v) { return v * sigmoid_f(v); }

__device__ __forceinline__ float row_rstd(const float* ss, int row, int fq) {
    const f32x4 v = *(const f32x4*)(ss + (size_t)row * 16 + fq * 4);
    float s = (v.x + v.y) + (v.z + v.w);
    s += __shfl_xor(s, 16); s += __shfl_xor(s, 32);
    return rsqrtf(s * (1.f / D) + NORM_EPS);
}

#define XB_TMO      128
#define XB_XCNT(j)  (256  + 64 * (j))
#define XB_XSUB(j)  (1280 + 64 * (j))
#define XB_XGEN(j)  (2304 + 64 * (j))
#define XB_TOP      3328
#define XB_TOPGEN   3392
#define XCD_BAR_WORDS 3456
#define XB_SPIN_CAP (1u << 18)

__device__ __forceinline__ unsigned xb_ld(unsigned* p)              { return __hip_atomic_load(p, __ATOMIC_RELAXED, __HIP_MEMORY_SCOPE_AGENT); }
__device__ __forceinline__ unsigned xb_add(unsigned* p, unsigned v) { return __hip_atomic_fetch_add(p, v, __ATOMIC_RELAXED, __HIP_MEMORY_SCOPE_AGENT); }
__device__ __forceinline__ unsigned xb_xcc_id() { return (unsigned)__builtin_amdgcn_s_getreg((3 << 11) | 20) & 0xFu; }
#define XB_SPIN(cond, bar) do { unsigned _sp = 0; while (cond) { __builtin_amdgcn_s_sleep(1); \
    if ((++_sp & 255u) == 0u) { if (xb_ld(&(bar)[XB_TMO])) break; if (_sp > XB_SPIN_CAP) { atomicAdd(&(bar)[XB_TMO], 1u); break; } } } } while (0)

struct XcdBarrier {
    unsigned* bar; unsigned x;
    volatile LAS unsigned* st;
};

__device__ __forceinline__ XcdBarrier xcd_barrier_post(unsigned* bar, volatile LAS unsigned* st) {
    XcdBarrier b; b.bar = bar; b.x = xb_xcc_id(); b.st = st;
    if (threadIdx.x == 0) (void)xb_add(&bar[XB_XCNT(b.x)], 1u);
    return b;
}
__device__ __forceinline__ void xcd_barrier_complete(unsigned* bar, unsigned x, unsigned& nloc, unsigned& nx) {
    const unsigned G = gridDim.x * gridDim.y * gridDim.z;
    unsigned sum, cnt, mine, sp = 0u;
    for (;;) {
        sum = 0u; cnt = 0u; mine = 0u;
#pragma unroll
        for (unsigned j = 0; j < 16; ++j) { const unsigned c = xb_ld(&bar[XB_XCNT(j)]); sum += c; cnt += (c > 0u) ? 1u : 0u; mine = (j == x) ? c : mine; }
        if (sum == G) break;
        __builtin_amdgcn_s_sleep(1);
        if ((++sp & 255u) == 0u) { if (xb_ld(&bar[XB_TMO])) break; if (sp > XB_SPIN_CAP) { atomicAdd(&bar[XB_TMO], 1u); break; } }
    }
    nloc = mine > 0u ? mine : 1u; nx = cnt > 0u ? cnt : 1u;
}

__device__ __forceinline__ void xcd_barrier(const XcdBarrier& b) {
    asm volatile("s_waitcnt vmcnt(0)" ::: "memory");
    __syncthreads();
    if (threadIdx.x == 0) {
        unsigned* bar = b.bar;
        __builtin_amdgcn_s_waitcnt(0);
        unsigned nloc = b.st[0], nx = b.st[1];
        if (nloc == 0u) { xcd_barrier_complete(bar, b.x, nloc, nx); b.st[0] = nloc; b.st[1] = nx; }
        const unsigned old = xb_add(&bar[XB_XSUB(b.x)], 1u);
        const unsigned gen = old / nloc;
        if (old + 1u == (gen + 1u) * nloc) {
            __builtin_amdgcn_fence(__ATOMIC_RELEASE, "agent");
            asm volatile("s_waitcnt vmcnt(0)" ::: "memory");
            const unsigned og = xb_add(&bar[XB_TOP], 1u);
            const unsigned tg = og / nx;
            if (og + 1u == (tg + 1u) * nx) xb_add(&bar[XB_TOPGEN], 1u);
            else XB_SPIN(xb_ld(&bar[XB_TOPGEN]) == tg, bar);
            __builtin_amdgcn_fence(__ATOMIC_ACQUIRE, "agent");
            xb_add(&bar[XB_XGEN(b.x)], 1u);
            asm volatile("s_waitcnt vmcnt(0)" ::: "memory");
        } else {
            XB_SPIN(xb_ld(&bar[XB_XGEN(b.x)]) == gen, bar);
            __builtin_amdgcn_fence(__ATOMIC_ACQUIRE, "agent");
            asm volatile("s_waitcnt vmcnt(0)" ::: "memory");
        }
    }
    __syncthreads();
}


constexpr int RSTD_OFF = 131072, LBT_OFF = 131072 + 1024, QKG_OFF = 131072 + 3072;
constexpr int XCH_A = QKG_OFF + 512, XCH_B = MISC_OFF + 64;
static_assert(XCH_A + 4096 <= MISC_OFF && XCH_B + 4096 <= LDS_BYTES, "LDS map above the GEMM stage region");
__device__ __forceinline__ void build_row_tables(LAS unsigned char* lds, const float* ss, int pm, const float* lbp, int layer, int tid, const float* qg = nullptr, const float* kg = nullptr) {
    { const int row = tid >> 1, half = tid & 1; const float* p = ss + (size_t)(pm * 256 + row) * 16 + half * 8;
      const f32x4 a = *(const f32x4*)p, b = *(const f32x4*)(p + 4);
      float s = ((a.x + a.y) + (a.z + a.w)) + ((b.x + b.y) + (b.z + b.w));
      s += __shfl_xor(s, 1);
      if (half == 0) ((LAS float*)(lds + RSTD_OFF))[row] = rsqrtf(s * (1.f / D) + NORM_EPS); }
    if (lbp && layer > 0) {
        const int c = tid;
        const float a0 = lbp[c], a1 = lbp[512 + c], a2 = lbp[1024 + c], a3 = lbp[1536 + c];
        const float mx = fmaxf(fmaxf(a0, a1), fmaxf(a2, a3));
        const float e0 = __expf(a0 - mx), e1 = __expf(a1 - mx), e2 = __expf(a2 - mx), e3 = __expf(a3 - mx);
        float cum = e1; if (layer >= 2) cum += e2; if (layer >= 3) cum += e3;
        ((LAS float*)(lds + LBT_OFF))[c] = cum / ((e0 + e1) + (e2 + e3));
    }
    if (qg && tid < 128) ((LAS float*)(lds + QKG_OFF))[tid] = (tid < 64) ? qg[tid] * (0.125f * LOG2E) : kg[tid - 64];
    __syncthreads();
}

template <bool TAB> struct EpiA {
    static constexpr bool PERM = true, AFTER_DRAIN = false;
    bf16_t* proj; const float* ss; const float* lbp; int layer; const LAS float* rtab; const LAS float* lbtab; LAS unsigned char* xlds;
    __device__ __forceinline__ void operator()(const pg8::f32x4 (&acc)[2][2][4][2], const pg8::Unit& u, int wr, int wc, int fr, int fq) const {
        const int seg = u.pn >> 1;
        const int row0 = u.pm * 256 + wr * 64 + fr, colb = u.pn * 256 + wc * 32 + 8 * fq;
        if constexpr (TAB) if (seg < 2) {
            typedef float f32x2e __attribute__((ext_vector_type(2)));
            float ps[2][4][2];
#pragma unroll
            for (int ai = 0; ai < 2; ++ai)
#pragma unroll
                for (int m = 0; m < 4; ++m) { const float rs0 = rtab[wr * 64 + fr + ai * 128 + m * 16];
#pragma unroll
                    for (int bj = 0; bj < 2; ++bj) { const pg8::f32x4 a0 = acc[ai][bj][m][0], a1 = acc[ai][bj][m][1];
                        float s = ((a0[0] * a0[0] + a0[1] * a0[1]) + (a0[2] * a0[2] + a0[3] * a0[3])) + ((a1[0] * a1[0] + a1[1] * a1[1]) + (a1[2] * a1[2] + a1[3] * a1[3]));
                        s += __shfl_xor(s, 16); s += __shfl_xor(s, 32); ps[ai][m][bj] = s * (rs0 * rs0); } }
            const int wv = wr * 4 + wc;
            LAS float* X = (LAS float*)(xlds + (wv < 4 ? XCH_A + wv * 1024 : XCH_B + (wv - 4) * 1024));
            const LAS float* Y = (const LAS float*)(xlds + ((wv ^ 1) < 4 ? XCH_A + (wv ^ 1) * 1024 : XCH_B + ((wv ^ 1) - 4) * 1024));
            if (fq == 0) {
#pragma unroll
                for (int ai = 0; ai < 2; ++ai)
#pragma unroll
                    for (int m = 0; m < 4; ++m)
#pragma unroll
                        for (int bj = 0; bj < 2; ++bj) X[((ai * 4 + m) * 2 + bj) * 16 + fr] = ps[ai][m][bj];
            }
            asm volatile("s_waitcnt lgkmcnt(0)\n\ts_barrier" ::: "memory");
            const LAS float* gp = (const LAS float*)(xlds + QKG_OFF) + seg * 64 + (wc & 1) * 32 + 8 * fq;
            const f32x4 g0 = *(const LAS f32x4*)gp, g1 = *(const LAS f32x4*)(gp + 4);
#pragma unroll
            for (int ai = 0; ai < 2; ++ai)
#pragma unroll
                for (int m = 0; m < 4; ++m) {
                    const int row = row0 + ai * 128 + m * 16; const float rs1 = rtab[wr * 64 + fr + ai * 128 + m * 16];
#pragma unroll
                    for (int bj = 0; bj < 2; ++bj) {
                        const float tot = ps[ai][m][bj] + Y[((ai * 4 + m) * 2 + bj) * 16 + fr];
                        const float r = rsqrtf(tot * (1.f / 64.f) + NORM_EPS) * rs1;
                        const pg8::f32x4 a0 = acc[ai][bj][m][0] * r * g0, a1 = acc[ai][bj][m][1] * r * g1;
                        u32x4 w; w.x = pg8::cvt_pk_bf16(a0[0], a0[1]); w.y = pg8::cvt_pk_bf16(a0[2], a0[3]); w.z = pg8::cvt_pk_bf16(a1[0], a1[1]); w.w = pg8::cvt_pk_bf16(a1[2], a1[3]);
                        *(u32x4*)(proj + (size_t)row * DIN + colb + bj * 128) = w;
                    }
                }
            return;
        }
        float lb[2][8];
#pragma unroll
        for (int bj = 0; bj < 2; ++bj)
#pragma unroll
            for (int j = 0; j < 8; ++j) lb[bj][j] = 0.f;
        if (seg == 4 && layer > 0) {
            if constexpr (TAB) {
#pragma unroll
                for (int bj = 0; bj < 2; ++bj) { const f32x4 t0 = *(const LAS f32x4*)(lbtab + colb + bj * 128 - C_F), t1 = *(const LAS f32x4*)(lbtab + colb + bj * 128 - C_F + 4);
#pragma unroll
                    for (int j = 0; j < 4; ++j) { lb[bj][j] = t0[j]; lb[bj][4 + j] = t1[j]; } }
            } else {
#pragma unroll
                for (int bj = 0; bj < 2; ++bj)
#pragma unroll
                    for (int j = 0; j < 8; ++j) {
                        const int c = colb + bj * 128 + j - C_F;
                        const float a0 = lbp[c], a1 = lbp[512 + c], a2 = lbp[1024 + c], a3 = lbp[1536 + c];
                        const float mx = fmaxf(fmaxf(a0, a1), fmaxf(a2, a3));
                        const float e0 = __expf(a0 - mx), e1 = __expf(a1 - mx), e2 = __expf(a2 - mx), e3 = __expf(a3 - mx);
                        float cum = e1; if (layer >= 2) cum += e2; if (layer >= 3) cum += e3;
                        lb[bj][j] = cum / ((e0 + e1) + (e2 + e3));
                    }
            }
        }
#pragma unroll
        for (int ai = 0; ai < 2; ++ai)
#pragma unroll
            for (int m = 0; m < 4; ++m) {
                const int row = row0 + ai * 128 + m * 16;
                float rstd; if constexpr (TAB) rstd = rtab[row - u.pm * 256]; else rstd = row_rstd(ss, row, fq);
#pragma unroll
                for (int bj = 0; bj < 2; ++bj) {
                    typedef float f32x2e __attribute__((ext_vector_type(2)));
                    f32x2e x2[4];
#pragma unroll
                    for (int q = 0; q < 4; ++q) { const pg8::f32x4 a = acc[ai][bj][m][q >> 1]; x2[q] = ((q & 1) ? (f32x2e){a[2], a[3]} : (f32x2e){a[0], a[1]}) * rstd; }
                    if (seg == 3 || seg == 6) {
#pragma unroll
                        for (int q = 0; q < 4; ++q) { const f32x2e t = x2[q] * (-LOG2E); f32x2e e; e.x = __builtin_amdgcn_exp2f(t.x); e.y = __builtin_amdgcn_exp2f(t.y);
                            const f32x2e d = e + 1.0f; f32x2e rc; rc.x = __builtin_amdgcn_rcpf(d.x); rc.y = __builtin_amdgcn_rcpf(d.y); x2[q] = x2[q] * rc; }
                    } else if (seg == 4) {
                        if (layer == 0) {
#pragma unroll
                            for (int q = 0; q < 4; ++q) { const f32x2e z = x2[q], t = __builtin_elementwise_abs(z) * (-LOG2E); f32x2e e; e.x = __builtin_amdgcn_exp2f(t.x); e.y = __builtin_amdgcn_exp2f(t.y);
                                const f32x2e d = e + 1.0f; f32x2e lg; lg.x = __builtin_amdgcn_logf(d.x); lg.y = __builtin_amdgcn_logf(d.y);
                                x2[q] = __builtin_elementwise_min(z, (f32x2e){0.f, 0.f}) - lg * 0.6931471805599453f; }
                        } else {
#pragma unroll
                            for (int q = 0; q < 4; ++q) { const f32x2e t = x2[q] * (-LOG2E); f32x2e e; e.x = __builtin_amdgcn_exp2f(t.x); e.y = __builtin_amdgcn_exp2f(t.y);
                                const f32x2e d = e + 1.0f; f32x2e rc; rc.x = __builtin_amdgcn_rcpf(d.x); rc.y = __builtin_amdgcn_rcpf(d.y);
                                const f32x2e l2 = (f32x2e){lb[bj][2 * q], lb[bj][2 * q + 1]}, a = l2 + (1.0f - l2) * rc; f32x2e lg; lg.x = __builtin_amdgcn_logf(a.x); lg.y = __builtin_amdgcn_logf(a.y);
                                x2[q] = lg * 0.6931471805599453f; }
                        }
                    }
                    u32x4 w; w.x = pg8::cvt_pk_bf16(x2[0].x, x2[0].y); w.y = pg8::cvt_pk_bf16(x2[1].x, x2[1].y); w.z = pg8::cvt_pk_bf16(x2[2].x, x2[2].y); w.w = pg8::cvt_pk_bf16(x2[3].x, x2[3].y);
                    *(u32x4*)(proj + (size_t)row * DIN + colb + bj * 128) = w;
                }
            }
    }
};
template <bool BASE_F32, bool LAST> struct EpiRes {
    static constexpr bool PERM = true, AFTER_DRAIN = false;
    const float* basef; bf16_t* xres; float* outf; float* ss;
    __device__ __forceinline__ void operator()(const pg8::f32x4 (&acc)[2][2][4][2], const pg8::Unit& u, int wr, int wc, int fr, int fq) const {
        const int row0 = u.pm * 256 + wr * 64 + fr, colb = u.pn * 256 + wc * 32 + 8 * fq;
#pragma unroll
        for (int ai = 0; ai < 2; ++ai)
#pragma unroll
            for (int m = 0; m < 4; ++m) {
                const int row = row0 + ai * 128 + m * 16; float s = 0.f;
#pragma unroll
                for (int bj = 0; bj < 2; ++bj) {
                    const size_t off = (size_t)row * D + colb + bj * 128;
                    f32x4 b0, b1;
                    if constexpr (BASE_F32) { b0 = __builtin_nontemporal_load((const f32x4*)(basef + off)); b1 = __builtin_nontemporal_load((const f32x4*)(basef + off + 4)); }
                    else { const u32x4 w = *(const u32x4*)(xres + off); b0 = (f32x4){bflo(w.x), bfhi(w.x), bflo(w.y), bfhi(w.y)}; b1 = (f32x4){bflo(w.z), bfhi(w.z), bflo(w.w), bfhi(w.w)}; }
                    const f32x4 v0 = acc[ai][bj][m][0] + b0, v1 = acc[ai][bj][m][1] + b1;
                    if constexpr (LAST) { *(f32x4*)(outf + off) = v0; *(f32x4*)(outf + off + 4) = v1; }
                    else {
                        s += (v0.x * v0.x + v0.y * v0.y) + (v0.z * v0.z + v0.w * v0.w) + (v1.x * v1.x + v1.y * v1.y) + (v1.z * v1.z + v1.w * v1.w);
                        u32x4 w; w.x = pg8::cvt_pk_bf16(v0.x, v0.y); w.y = pg8::cvt_pk_bf16(v0.z, v0.w); w.z = pg8::cvt_pk_bf16(v1.x, v1.y); w.w = pg8::cvt_pk_bf16(v1.z, v1.w);
                        *(u32x4*)(xres + off) = w; }
                }
                if constexpr (!LAST) { s += __shfl_xor(s, 16); s += __shfl_xor(s, 32); if (fq == 0) ss[(size_t)row * 16 + u.pn * 4 + wc] = s; }
            }
    }
};
template <bool TAB> struct EpiGU {
    static constexpr bool PERM = true, AFTER_DRAIN = false;
    bf16_t* h; const float* ss; const LAS float* rtab;
    __device__ __forceinline__ void operator()(const pg8::f32x4 (&acc)[2][2][4][2], const pg8::Unit& u, int wr, int wc, int fr, int fq) const {
        const int row0 = u.pm * 256 + wr * 64 + fr, col = u.pn * 128 + wc * 32 + 8 * fq;
#pragma unroll
        for (int ai = 0; ai < 2; ++ai)
#pragma unroll
            for (int m = 0; m < 4; ++m) {
                const int row = row0 + ai * 128 + m * 16;
                float rstd; if constexpr (TAB) rstd = rtab[row - u.pm * 256]; else rstd = row_rstd(ss, row, fq);
                const float nl = -rstd * LOG2E, r2 = rstd * rstd;
                typedef float f32x2e __attribute__((ext_vector_type(2)));
                f32x2e o2[4];
#pragma unroll
                for (int q = 0; q < 4; ++q) {
                    const pg8::f32x4 gq = acc[ai][0][m][q >> 1], uq = acc[ai][1][m][q >> 1];
                    const f32x2e g2 = (q & 1) ? (f32x2e){gq[2], gq[3]} : (f32x2e){gq[0], gq[1]}, u2 = (q & 1) ? (f32x2e){uq[2], uq[3]} : (f32x2e){uq[0], uq[1]};
                    const f32x2e t = g2 * nl; f32x2e e; e.x = __builtin_amdgcn_exp2f(t.x); e.y = __builtin_amdgcn_exp2f(t.y);
                    const f32x2e d = e + 1.0f; f32x2e rc; rc.x = __builtin_amdgcn_rcpf(d.x); rc.y = __builtin_amdgcn_rcpf(d.y);
                    o2[q] = ((g2 * u2) * r2) * rc;
                }
                u32x4 w; w.x = pg8::cvt_pk_bf16(o2[0].x, o2[0].y); w.y = pg8::cvt_pk_bf16(o2[1].x, o2[1].y); w.z = pg8::cvt_pk_bf16(o2[2].x, o2[2].y); w.w = pg8::cvt_pk_bf16(o2[3].x, o2[3].y);
                *(u32x4*)(h + (size_t)row * FF + col) = w;
            }
    }
};

__device__ __forceinline__ void convert_macro(const float* __restrict__ W, const float* __restrict__ gk, int K, int N, bf16_t* WT, int k0, int n0, int mode, LAS float* scr, int tid) {
    float r[32];
#pragma unroll
    for (int i = 0; i < 32; ++i) r[i] = __builtin_nontemporal_load(W + (size_t)(k0 + i * 2 + (tid >> 8)) * N + n0 + (tid & 255));
#pragma unroll
    for (int i = 0; i < 32; ++i) { const int k = i * 2 + (tid >> 8); scr[k * 257 + (tid & 255)] = r[i] * (gk ? gk[k0 + k] : 1.f); }
    __syncthreads();
    const int c = tid & 7;
#pragma unroll
    for (int j = 0; j < 4; ++j) {
        const int nn = (tid >> 3) + 64 * j, nb = n0 + 64 * j;
        const int drow = (mode == 0) ? nb + (tid >> 3) : (nb / 128) * 256 + (nb % 128) + (mode == 2 ? 128 : 0) + (tid >> 3);
        const LAS float* s = scr + (8 * c) * 257 + nn;
        u32x4 o; o.x = pk2(s[0], s[257]); o.y = pk2(s[514], s[771]); o.z = pk2(s[1028], s[1285]); o.w = pk2(s[1542], s[1799]);
        *(u32x4*)(WT + (size_t)drow * K + k0 + 8 * c) = o;
    }
    __syncthreads();
}
constexpr int CV_IN = 16 * 14, CV_OUT = 16 * 4, CV_G = 16 * 11, CV_DN = 44 * 4;

template <int R> __device__ __forceinline__ void prologue_rows(const float* xrow, bf16_t* xgrow, float* ssrow, int lane) {
    f32x4 v[R][4];
#pragma unroll
    for (int q = 0; q < R; ++q)
#pragma unroll
        for (int j = 0; j < 4; ++j) v[q][j] = __builtin_nontemporal_load((const f32x4*)(xrow + (size_t)q * D) + lane + 64 * j);
#pragma unroll
    for (int q = 0; q < R; ++q) {
        float s = 0.f;
#pragma unroll
        for (int j = 0; j < 4; ++j) { const f32x4 w = v[q][j]; s += (w.x * w.x + w.y * w.y) + (w.z * w.z + w.w * w.w);
            u32x2 o; o.x = pk2(w.x, w.y); o.y = pk2(w.z, w.w); ((u32x2*)(xgrow + (size_t)q * D))[lane + 64 * j] = o; }
        s = wave_sum(s);
        if (lane < 16) ssrow[q * 16 + lane] = (lane == 0) ? s : 0.f;
    }
}
template <int R> __device__ __forceinline__ void qknorm_rows(bf16_t* prow, const float* qg, const float* kg, int lane) {
    bf16_t* p = prow + lane * 16;
    u32x4 a[R], b[R];
#pragma unroll
    for (int q = 0; q < R; ++q) { a[q] = *(const u32x4*)(p + (size_t)q * DIN); b[q] = *(const u32x4*)(p + (size_t)q * DIN + 8); }
    const float* g = (lane < 32 ? qg : kg) + (lane & 3) * 16;
    float gv[16];
#pragma unroll
    for (int i = 0; i < 16; ++i) gv[i] = g[i];
#pragma unroll
    for (int q = 0; q < R; ++q) {
        float v[16];
#pragma unroll
        for (int i = 0; i < 4; ++i) { v[2 * i] = bflo(a[q][i]); v[2 * i + 1] = bfhi(a[q][i]); v[8 + 2 * i] = bflo(b[q][i]); v[8 + 2 * i + 1] = bfhi(b[q][i]); }
        float s = 0.f;
#pragma unroll
        for (int i = 0; i < 16; ++i) s += v[i] * v[i];
        s += __shfl_xor(s, 1); s += __shfl_xor(s, 2);
        const float r = rsqrtf(s * (1.f / 64.f) + NORM_EPS) * (lane < 32 ? 0.125f * LOG2E : 1.f);
        u32x4 oa, ob;
#pragma unroll
        for (int i = 0; i < 4; ++i) { oa[i] = pk2(v[2 * i] * r * gv[2 * i], v[2 * i + 1] * r * gv[2 * i + 1]); ob[i] = pk2(v[8 + 2 * i] * r * gv[8 + 2 * i], v[8 + 2 * i + 1] * r * gv[8 + 2 * i + 1]); }
        *(u32x4*)(p + (size_t)q * DIN) = oa; *(u32x4*)(p + (size_t)q * DIN + 8) = ob;
    }
}
template <int R> __device__ __forceinline__ void combine_rows(const bf16_t* Orow, bf16_t* mixrow, const float* subg, float lam, float oscale, int lane) {
    const int h = lane >> 4, d0 = (lane & 15) * 8;
    u32x4 a[R], b[R];
#pragma unroll
    for (int q = 0; q < R; ++q) { a[q] = *(const u32x4*)(Orow + (size_t)q * D + (2 * h) * 128 + d0); b[q] = *(const u32x4*)(Orow + (size_t)q * D + (2 * h + 1) * 128 + d0); }
    const f32x4 g0 = *(const f32x4*)(subg + d0), g1 = *(const f32x4*)(subg + d0 + 4);
    const float gv[8] = {g0.x, g0.y, g0.z, g0.w, g1.x, g1.y, g1.z, g1.w};
#pragma unroll
    for (int q = 0; q < R; ++q) {
        float v[8]; float s = 0.f;
#pragma unroll
        for (int i = 0; i < 4; ++i) { v[2 * i] = bflo(a[q][i]) - lam * bflo(b[q][i]); v[2 * i + 1] = bfhi(a[q][i]) - lam * bfhi(b[q][i]); }
#pragma unroll
        for (int i = 0; i < 8; ++i) s += v[i] * v[i];
        s += __shfl_xor(s, 1); s += __shfl_xor(s, 2); s += __shfl_xor(s, 4); s += __shfl_xor(s, 8);
        const float r = rsqrtf(s * (1.f / 128.f) + NORM_EPS) * oscale;
        u32x4 o;
#pragma unroll
        for (int i = 0; i < 4; ++i) o[i] = pk2(v[2 * i] * r * gv[2 * i], v[2 * i + 1] * r * gv[2 * i + 1]);
        *(u32x4*)(mixrow + (size_t)q * D + h * 128 + d0) = o;
    }
}
#if HGRN_NAIVE
__device__ __forceinline__ void hgrn_norm_row(bf16_t* mixrow, const bf16_t* projrow, const float* hg, int lane) {
    const int h = lane >> 4, d0 = (lane & 15) * 8;
    const u32x4 c = *(const u32x4*)(mixrow + 512 + h * 128 + d0), gg = *(const u32x4*)(projrow + C_G + h * 128 + d0);
    float v[8]; float s = 0.f;
#pragma unroll
    for (int i = 0; i < 4; ++i) { v[2 * i] = bflo(c[i]); v[2 * i + 1] = bfhi(c[i]); }
#pragma unroll
    for (int i = 0; i < 8; ++i) s += v[i] * v[i];
    s += __shfl_xor(s, 1); s += __shfl_xor(s, 2); s += __shfl_xor(s, 4); s += __shfl_xor(s, 8);
    const float r = rsqrtf(s * (1.f / 128.f) + NORM_EPS);
    u32x4 o;
#pragma unroll
    for (int i = 0; i < 4; ++i) o[i] = pk2(v[2 * i] * r * hg[d0 + 2 * i] * bflo(gg[i]), v[2 * i + 1] * r * hg[d0 + 2 * i + 1] * bfhi(gg[i]));
    *(u32x4*)(mixrow + 512 + h * 128 + d0) = o;
}
#endif
__device__ __forceinline__ void hgrn_naive(LAS float* sm, const bf16_t* proj, bf16_t* mix, int bh, int tid) {
    const int b = bh >> 2, h = bh & 3;
    LAS float* sf = sm; LAS float* sk = sm + 2048; LAS float* sq = sm + 4096; LAS float* sv = sm + 6144; LAS float* so = sm + 8192;
    const int v = tid & 127, kq = tid >> 7;
    float S[32];
#pragma unroll
    for (int j = 0; j < 32; ++j) S[j] = 0.f;
    for (int t0 = 0; t0 < SEQ; t0 += 16) {
        for (int e = tid; e < 2048; e += NTHR) { const int tt = e >> 7, k = e & 127; const bf16_t* r = proj + (size_t)(b * SEQ + t0 + tt) * DIN + h * 128 + k;
            const float lf = bf2f(r[C_F]); sf[e] = __expf(lf); sk[e] = -expm1f(lf); sq[e] = bf2f(r[C_HQ]); sv[e] = bf2f(r[C_I]); }
        __syncthreads();
        for (int tt = 0; tt < 16; ++tt) { float acc = 0.f; const float vv = sv[tt * 128 + v];
#pragma unroll
            for (int j = 0; j < 32; ++j) { const int k = tt * 128 + kq * 32 + j; S[j] = sf[k] * S[j] + sk[k] * vv; acc += sq[k] * S[j]; }
            so[(tt * 4 + kq) * 128 + v] = acc; }
        __syncthreads();
        for (int e = tid; e < 2048; e += NTHR) { const int tt = e >> 7, vc = e & 127;
            const float o = (so[(tt * 4 + 0) * 128 + vc] + so[(tt * 4 + 1) * 128 + vc]) + (so[(tt * 4 + 2) * 128 + vc] + so[(tt * 4 + 3) * 128 + vc]);
            mix[(size_t)(b * SEQ + t0 + tt) * D + 512 + h * 128 + vc] = (bf16_t)f2bf(o); }
    }
    __syncthreads();
}


typedef short hbf16x8 __attribute__((ext_vector_type(8)));
typedef float hf32x16 __attribute__((ext_vector_type(16)));
constexpr int HS_K = 272, HS_V = 144;
constexpr int HL_BF = 0, HL_QD = 32768, HL_KD = HL_QD + 64 * HS_K, HL_KO = HL_KD + 64 * HS_K, HL_QE = HL_KO + 32 * HS_K, HL_VT = HL_QE + 32 * HS_K, HL_KT = HL_VT + 128 * HS_V,
              HL_TOT = HL_KT + 128 * HS_V, HL_PART = HL_TOT + 2048, HL_END = HL_PART + 1024;
static_assert(HL_END <= 131072, "HGRN LDS map");
__device__ __forceinline__ int crow16(int r, int hi) { return (r & 3) + 8 * (r >> 2) + 4 * hi; }

__device__ __forceinline__ void hgrn_load1(const bf16_t* proj, int b, int h, int ch, int tid, unsigned short (&lr)[16], unsigned short (&vr)[16]) {
    const int col = tid & 127, seg = tid >> 7;
    const bf16_t* base = proj + (size_t)(b * SEQ + ch * 64 + seg * 16) * DIN + h * 128 + col;
#pragma unroll
    for (int i = 0; i < 16; ++i) { lr[i] = base[(size_t)i * DIN + C_F]; vr[i] = base[(size_t)i * DIN + C_I]; }
}
__device__ __forceinline__ void hgrn_pass1(LAS unsigned char* L, int tid, const unsigned short (&lr)[16], const unsigned short (&vr)[16], float (&cum)[16], float (&lf)[16], float& blast) {
    const int col = tid & 127, seg = tid >> 7;
    float cs = 0.f;
#pragma unroll
    for (int i = 0; i < 16; ++i) { lf[i] = bf2f(lr[i]); cs += lf[i]; cum[i] = cs; }
    LAS float* TOT = (LAS float*)(L + HL_TOT);
    TOT[seg * 128 + col] = cs;
    { u32x4 w0, w1;
#pragma unroll
      for (int i = 0; i < 4; ++i) { w0[i] = (unsigned)vr[2 * i] | ((unsigned)vr[2 * i + 1] << 16); w1[i] = (unsigned)vr[8 + 2 * i] | ((unsigned)vr[8 + 2 * i + 1] << 16); }
      LAS unsigned char* vp = L + HL_VT + col * HS_V + seg * 32;
      *(LAS u32x4*)vp = w0; *(LAS u32x4*)(vp + 16) = w1; }
    __syncthreads();
    const float t0 = TOT[col], t1 = TOT[128 + col], t2 = TOT[256 + col], t3 = TOT[384 + col];
    const float off = (seg > 0 ? t0 : 0.f) + (seg > 1 ? t1 : 0.f) + (seg > 2 ? t2 : 0.f);
    blast = (t0 + t1) + (t2 + t3);
#pragma unroll
    for (int i = 0; i < 16; ++i) cum[i] += off;
}
__device__ __forceinline__ void hgrn_stage1(LAS unsigned char* L, const bf16_t* proj, bf16_t* ST, float* Dbuf, int item, int tid) {
    const int bh = item >> 6, ch = item & 63, b = bh >> 2, h = bh & 3, col = tid & 127, seg = tid >> 7;
    const int lane = tid & 63, wave = __builtin_amdgcn_readfirstlane(tid >> 6), r = lane & 31, hh = lane >> 5;
    float cum[16], lf[16], blast;
    { unsigned short lr[16], vr[16]; hgrn_load1(proj, b, h, ch, tid, lr, vr); hgrn_pass1(L, tid, lr, vr, cum, lf, blast); }
    { u32x4 w0, w1; float ke[16];
#pragma unroll
      for (int i = 0; i < 16; ++i) ke[i] = (1.f - __expf(lf[i])) * __expf(blast - cum[i]);
#pragma unroll
      for (int i = 0; i < 4; ++i) { w0[i] = pk2(ke[2 * i], ke[2 * i + 1]); w1[i] = pk2(ke[8 + 2 * i], ke[8 + 2 * i + 1]); }
      LAS unsigned char* kp = L + HL_KT + col * HS_V + seg * 32;
      *(LAS u32x4*)kp = w0; *(LAS u32x4*)(kp + 16) = w1;
      if (seg == 0) Dbuf[(size_t)item * 128 + col] = __expf(blast); }
    __syncthreads();
    const int vb = wave & 3;
#pragma unroll
    for (int q = 0; q < 2; ++q) {
        const int kb = (wave >> 2) * 2 + q;
        hf32x16 acc = {};
        const LAS unsigned char* ap = L + HL_VT + (vb * 32 + r) * HS_V + hh * 16;
        const LAS unsigned char* bp = L + HL_KT + (kb * 32 + r) * HS_V + hh * 16;
#pragma unroll
        for (int s0 = 0; s0 < 4; ++s0) acc = __builtin_amdgcn_mfma_f32_32x32x16_bf16(*(const LAS hbf16x8*)(ap + s0 * 32), *(const LAS hbf16x8*)(bp + s0 * 32), acc, 0, 0, 0);
        bf16_t* out = ST + ((size_t)item * 128 + vb * 32) * 128 + kb * 32 + r;
#pragma unroll
        for (int g = 0; g < 16; ++g) out[(size_t)crow16(g, hh) * 128] = (bf16_t)f2bf(acc[g]);
    }
    __syncthreads();
}
typedef float hf32x2 __attribute__((ext_vector_type(2)));
__device__ __forceinline__ void hgrn_scan_row(bf16_t* ST, const float* Dbuf, int rowid, int lane) {
    const int bh = rowid >> 7, v = rowid & 127;
    unsigned* sp = (unsigned*)(ST + ((size_t)(bh * 64) * 128 + v) * 128) + lane;
    const hf32x2* dp = (const hf32x2*)(Dbuf + (size_t)(bh * 64) * 128) + lane;
    float s0 = 0.f, s1 = 0.f;
    for (int c0 = 0; c0 < 64; c0 += 16) {
        unsigned u[16]; hf32x2 d[16];
#pragma unroll
        for (int i = 0; i < 16; ++i) { u[i] = sp[(size_t)(c0 + i) * 8192]; d[i] = dp[(c0 + i) * 64]; }
#pragma unroll
        for (int i = 0; i < 16; ++i) { sp[(size_t)(c0 + i) * 8192] = pk2(s0, s1); s0 = d[i].x * s0 + bflo(u[i]); s1 = d[i].y * s1 + bfhi(u[i]); }
    }
}
__device__ __forceinline__ void hgrn_stage3(LAS unsigned char* L, const bf16_t* proj, const bf16_t* ST, bf16_t* mix, const float* hg, int item, int tid) {
    const int bh = item >> 6, ch = item & 63, b = bh >> 2, h = bh & 3, col = tid & 127, seg = tid >> 7;
    const int lane = tid & 63, wave = __builtin_amdgcn_readfirstlane(tid >> 6), r = lane & 31, hh = lane >> 5;
    const int vb = wave & 3, tb = wave >> 2;
    unsigned short lr[16], vr[16];
    hgrn_load1(proj, b, h, ch, tid, lr, vr);
    u32x4 qw2[2], fw2[2];
#pragma unroll
    for (int half = 0; half < 2; ++half) { const bf16_t* rowp = proj + (size_t)(b * SEQ + ch * 64 + (tid >> 4) + 32 * half) * DIN + h * 128 + (tid & 15) * 8;
        qw2[half] = *(const u32x4*)(rowp + C_HQ); fw2[half] = *(const u32x4*)(rowp + C_F); }
    hbf16x8 sfr[8];
    { const bf16_t* sg = ST + ((size_t)item * 128 + vb * 32 + r) * 128 + hh * 8;
#pragma unroll
      for (int kk = 0; kk < 8; ++kk) sfr[kk] = *(const hbf16x8*)(sg + kk * 16); }
    u32x2 gate2[4];
#pragma unroll
    for (int g = 0; g < 4; ++g) gate2[g] = *(const u32x2*)(proj + (size_t)(b * SEQ + ch * 64 + tb * 32 + r) * DIN + C_G + h * 128 + vb * 32 + 8 * g + 4 * hh);
    {
        float cum[16], lf[16], blast;
        hgrn_pass1(L, tid, lr, vr, cum, lf, blast);
        LAS float* BF = (LAS float*)(L + HL_BF);
#pragma unroll
        for (int i = 0; i < 16; ++i) BF[(seg * 16 + i) * 128 + col] = cum[i];
    }
    __syncthreads();
    {
        const int kvec = tid & 15;
        const LAS float* BF = (const LAS float*)(L + HL_BF);
        float b31[8];
        { const f32x4 x0 = *(const LAS f32x4*)(BF + 31 * 128 + kvec * 8), x1 = *(const LAS f32x4*)(BF + 31 * 128 + kvec * 8 + 4);
#pragma unroll
          for (int j = 0; j < 4; ++j) { b31[j] = x0[j]; b31[4 + j] = x1[j]; } }
#pragma unroll
        for (int half = 0; half < 2; ++half) {
            const int t = (tid >> 4) + 32 * half;
            const u32x4 qw = qw2[half], fw = fw2[half];
            const f32x4 y0 = *(const LAS f32x4*)(BF + t * 128 + kvec * 8), y1 = *(const LAS f32x4*)(BF + t * 128 + kvec * 8 + 4);
            float qd[8], kd[8], xx[8];
#pragma unroll
            for (int j = 0; j < 8; ++j) {
                const float q = (j & 1) ? bfhi(qw[j >> 1]) : bflo(qw[j >> 1]), lfj = (j & 1) ? bfhi(fw[j >> 1]) : bflo(fw[j >> 1]);
                const float bb = (j < 4) ? y0[j & 3] : y1[j & 3], kk = 1.f - __expf(lfj);
                const float rr = half ? b31[j] : 0.f;
                qd[j] = q * __expf(bb - rr); kd[j] = kk * __expf(fminf(rr - bb, 85.f));
                xx[j] = half ? q * __expf(bb) : kk * __expf(b31[j] - bb);
            }
            u32x4 w;
#pragma unroll
            for (int i = 0; i < 4; ++i) w[i] = pk2(qd[2 * i], qd[2 * i + 1]);
            *(LAS u32x4*)(L + HL_QD + t * HS_K + kvec * 16) = w;
#pragma unroll
            for (int i = 0; i < 4; ++i) w[i] = pk2(kd[2 * i], kd[2 * i + 1]);
            *(LAS u32x4*)(L + HL_KD + t * HS_K + kvec * 16) = w;
#pragma unroll
            for (int i = 0; i < 4; ++i) w[i] = pk2(xx[2 * i], xx[2 * i + 1]);
            *(LAS u32x4*)(L + (half ? HL_QE : HL_KO) + (t & 31) * HS_K + kvec * 16) = w;
        }
    }
    __syncthreads();
    hf32x16 o = {};
    for (int sb = 0; sb <= tb; ++sb) {
        hf32x16 X = {};
        const LAS unsigned char* ap = (sb == tb) ? (L + HL_KD + (sb * 32 + r) * HS_K + hh * 16) : (L + HL_KO + r * HS_K + hh * 16);
        const LAS unsigned char* bp = L + HL_QD + (tb * 32 + r) * HS_K + hh * 16;
#pragma unroll
        for (int kk = 0; kk < 8; ++kk) X = __builtin_amdgcn_mfma_f32_32x32x16_bf16(*(const LAS hbf16x8*)(ap + kk * 32), *(const LAS hbf16x8*)(bp + kk * 32), X, 0, 0, 0);
        if (sb == tb) {
#pragma unroll
            for (int g = 0; g < 16; ++g) if (crow16(g, hh) > r) X[g] = 0.f;
        }
#pragma unroll
        for (int sp = 0; sp < 2; ++sp) {
            u32x4 pw;
#pragma unroll
            for (int i = 0; i < 4; ++i) pw[i] = pk2(X[8 * sp + 2 * i], X[8 * sp + 2 * i + 1]);
            const LAS unsigned char* vp = L + HL_VT + (vb * 32 + r) * HS_V + (sb * 32 + 16 * sp + 4 * hh) * 2;
            const u32x2 lo = *(const LAS u32x2*)vp, hi = *(const LAS u32x2*)(vp + 16);
            u32x4 aw; aw.x = lo.x; aw.y = lo.y; aw.z = hi.x; aw.w = hi.y;
            o = __builtin_amdgcn_mfma_f32_32x32x16_bf16(__builtin_bit_cast(hbf16x8, aw), __builtin_bit_cast(hbf16x8, pw), o, 0, 0, 0);
        }
    }
    {
        const LAS unsigned char* qb = L + (tb ? HL_QE : HL_QD) + r * HS_K + hh * 16;
#pragma unroll
        for (int kk = 0; kk < 8; ++kk) o = __builtin_amdgcn_mfma_f32_32x32x16_bf16(sfr[kk], *(const LAS hbf16x8*)(qb + kk * 32), o, 0, 0, 0);
    }
    LAS float* PART = (LAS float*)(L + HL_PART);
    { float sq = 0.f;
#pragma unroll
      for (int g = 0; g < 16; ++g) sq += o[g] * o[g];
      sq += __shfl_xor(sq, 32);
      if (hh == 0) PART[vb * 64 + tb * 32 + r] = sq; }
    __syncthreads();
    {
        const int t = tb * 32 + r;
        const float tot = (PART[t] + PART[64 + t]) + (PART[128 + t] + PART[192 + t]);
        const float rstd = rsqrtf(tot * (1.f / 128.f) + NORM_EPS);
        const size_t row = (size_t)(b * SEQ + ch * 64 + t);
#pragma unroll
        for (int g = 0; g < 4; ++g) {
            const int v0 = vb * 32 + 8 * g + 4 * hh;
            const u32x2 gate = gate2[g]; const f32x4 gn = *(const f32x4*)(hg + v0);
            u32x2 w; w.x = pk2(o[4 * g] * rstd * gn.x * bflo(gate.x), o[4 * g + 1] * rstd * gn.y * bfhi(gate.x)); w.y = pk2(o[4 * g + 2] * rstd * gn.z * bflo(gate.y), o[4 * g + 3] * rstd * gn.w * bfhi(gate.y));
            *(u32x2*)(mix + row * D + 512 + h * 128 + v0) = w;
        }
    }
    __syncthreads();
}

struct Params { const float* in[17]; float* out; unsigned char* ws; int ph_lo, ph_hi; };
enum { I_X = 0, I_ATTN_G, I_WIN, I_QG, I_KG, I_LQ1, I_LK1, I_LQ2, I_LK2, I_SUBG, I_LB, I_HG, I_WOUT, I_FFN_G, I_WGATE, I_WUP, I_WDOWN };

__global__ void __launch_bounds__(NTHR, 2) fwd_megakernel(Params p) {
    extern __shared__ __attribute__((aligned(16))) unsigned char lds[];
    cg::grid_group grid = cg::this_grid();
    const int G = gridDim.x, bx = blockIdx.x;
    const int vcu = (G % 8 == 0) ? (bx % 8) * (G / 8) + bx / 8 : bx;
    const int NGW = G * NWAVES;
    unsigned char* ws = p.ws;
    bf16_t* win_t = (bf16_t*)(ws + WS_WIN); bf16_t* wout_t = (bf16_t*)(ws + WS_WOUT); bf16_t* wgu_t = (bf16_t*)(ws + WS_WGU); bf16_t* wdn_t = (bf16_t*)(ws + WS_WDN);
    float* ss = (float*)(ws + WS_SS); bf16_t* xg = (bf16_t*)(ws + WS_XG); bf16_t* Obuf = (bf16_t*)p.out;     bf16_t* proj = (bf16_t*)(ws + WS_PROJ); bf16_t* hbuf = proj; bf16_t* mix = (bf16_t*)(ws + WS_MIX); bf16_t* stbuf = (bf16_t*)(ws + WS_ST); float* dbuf = (float*)ws;
    LAS unsigned char* ldsl = (LAS unsigned char*)lds;
    volatile LAS unsigned* MISC = (volatile LAS unsigned*)(ldsl + MISC_OFF);
    if (threadIdx.x < 4) MISC[threadIdx.x] = 0u;
    __syncthreads();
    XcdBarrier xbar = xcd_barrier_post((unsigned*)(ws + WS_BAR), MISC);

    for (int ph = p.ph_lo; ph < p.ph_hi; ++ph) {
        if (ph % PH_PER_LAYER == 0 && ph > 0) continue;
        if (ph > p.ph_lo) {
            if (p.ph_hi > N_PHASES) grid.sync();
            xcd_barrier(xbar); if (DUPMASK & 256) xcd_barrier(xbar); }
        const int l = ph / PH_PER_LAYER, k = ph % PH_PER_LAYER;
        int tid = threadIdx.x; asm volatile("" : "+v"(tid));
        int Gl = G; asm volatile("" : "+s"(Gl));
        const int lane = tid & 63, wave = __builtin_amdgcn_readfirstlane(tid >> 6), gw = vcu * NWAVES + wave;
        if (k == 0 && (PHMASK & 1)) {
            LAS float* scr = (LAS float*)ldsl;
            for (int rep = 0; rep < NREP(0); ++rep)
            for (int it = bx; it < CV_IN + CV_OUT; it += G) {
                if (it < CV_IN) convert_macro(p.in[I_WIN], p.in[I_ATTN_G], D, DIN, win_t, (it / 14) * 64, (it % 14) * 256, 0, scr, tid);
                else { const int r = it - CV_IN; convert_macro(p.in[I_WOUT], nullptr, D, D, wout_t, (r / 4) * 64, (r % 4) * 256, 0, scr, tid); }
            }
            for (int m = gw * 4; m < M; m += NGW * 4) prologue_rows<4>(p.in[I_X] + (size_t)m * D, xg + (size_t)m * D, ss + (size_t)m * 16, lane);
        } else if (k == 1 && (PHMASK & 2)) {
            const int remA = ((M / 256) * (DIN / 256)) % G, firstA = remA ? remA : 0, nconvA = remA ? G - remA : G;
            const int nmyA = (bx >= firstA) ? (2 * CV_G - (bx - firstA) + nconvA - 1) / nconvA : 0, npreA = (nmyA + 1) / 2;
            { LAS float* scr = (LAS float*)ldsl;
              for (int j = 0; j < npreA; ++j) {
                  int r = bx - firstA + j * nconvA;
                  if (r < CV_G) { convert_macro(p.in[I_WGATE] + (size_t)l * D * FF, p.in[I_FFN_G] + l * D, D, FF, wgu_t, (r / 11) * 64, (r % 11) * 256, 1, scr, tid); continue; } r -= CV_G;
                  if (r < CV_G) { convert_macro(p.in[I_WUP] + (size_t)l * D * FF, p.in[I_FFN_G] + l * D, D, FF, wgu_t, (r / 11) * 64, (r % 11) * 256, 2, scr, tid); continue; } r -= CV_G;
                  convert_macro(p.in[I_WDOWN] + (size_t)l * FF * D, nullptr, FF, D, wdn_t, (r / 4) * 64, (r % 4) * 256, 0, scr, tid);
              } }
            pg8::Gemm g{xg, win_t, M, DIN, D}; pg8::StaticOrder S; S.init(M, DIN, G, bx);
            if (Gl == 256) {
                pg8::Unit u0; S.next(0, u0); build_row_tables(ldsl, ss, u0.pm, p.in[I_LB], l, tid, p.in[I_QG] + l * 64, p.in[I_KG] + l * 64);
                EpiA<true> E{proj, ss, p.in[I_LB], l, (const LAS float*)(ldsl + RSTD_OFF), (const LAS float*)(ldsl + LBT_OFF), ldsl};
                for (int rep = 0; rep < NREP(1); ++rep) pg8::gemm_phase<EpiA<true>, pg8::StaticOrder, true, true>(ldsl, g, S, E);
            } else {
                EpiA<false> E{proj, ss, p.in[I_LB], l, nullptr, nullptr, nullptr};
                pg8::gemm_phase<EpiA<false>, pg8::StaticOrder, true, true>(ldsl, g, S, E);
            }
            { LAS float* scr = (LAS float*)ldsl;
              for (int j = npreA; j < nmyA; ++j) {
                  int r = bx - firstA + j * nconvA;
                  if (r < CV_G) { convert_macro(p.in[I_WGATE] + (size_t)l * D * FF, p.in[I_FFN_G] + l * D, D, FF, wgu_t, (r / 11) * 64, (r % 11) * 256, 1, scr, tid); continue; } r -= CV_G;
                  if (r < CV_G) { convert_macro(p.in[I_WUP] + (size_t)l * D * FF, p.in[I_FFN_G] + l * D, D, FF, wgu_t, (r / 11) * 64, (r % 11) * 256, 2, scr, tid); continue; } r -= CV_G;
                  convert_macro(p.in[I_WDOWN] + (size_t)l * FF * D, nullptr, FF, D, wdn_t, (r / 4) * 64, (r % 4) * 256, 0, scr, tid);
              } }
        } else if (k == 2 && (PHMASK & 4)) {
#if HGRN_NAIVE
            if (bx < 16) hgrn_naive((LAS float*)ldsl, proj, mix, bx, tid);
            else for (int m = ((bx - 16) * NWAVES + wave) * 4; m < M; m += (G - 16) * NWAVES * 4) qknorm_rows<4>(proj + (size_t)m * DIN, p.in[I_QG] + l * 64, p.in[I_KG] + l * 64, lane);
#else
            if (Gl != 256) for (int m = gw * 8; m < M; m += NGW * 8) qknorm_rows<8>(proj + (size_t)m * DIN, p.in[I_QG] + l * 64, p.in[I_KG] + l * 64, lane);
            for (int rep = 0; rep < NREP(2); ++rep)
            for (int it = vcu; it < 1024; it += G) hgrn_stage1(ldsl, proj, stbuf, dbuf, it, tid);
#endif
        } else if (k == 3 && (PHMASK & 8)) {
            for (int rep = 0; rep < NREP(3); ++rep)
            for (int it = vcu; it < 256; it += G) {
                const int bq = it >> 3, s = it & 7, b = bq >> 3, qh = bq & 7, h = qh >> 1;
                for (int j = 0; j < 2; ++j) {
                    attn_body::attn_unit<8>(b, C_Q + qh * 64, C_K + qh * 64, C_V + h * 128, qh * 128, j ? s : 15 - s, (const attn_body::bf16*)proj, (attn_body::bf16*)Obuf, (char*)lds);
#if !HGRN_NAIVE
                    if (j == 0 && it == vcu) { int t2 = threadIdx.x; asm volatile("" : "+v"(t2));
                        const int wv2 = __builtin_amdgcn_readfirstlane(t2 >> 6);
                        for (int rowid = vcu * NWAVES + wv2; rowid < 16 * 128; rowid += NGW) hgrn_scan_row(stbuf, dbuf, rowid, t2 & 63); }
#endif
                }
            }
#if !HGRN_NAIVE
            if (vcu >= 256) for (int rowid = gw; rowid < 16 * 128; rowid += NGW) hgrn_scan_row(stbuf, dbuf, rowid, lane);
#endif
        } else if (k == 4 && (PHMASK & 16)) {
            const float li = 0.8f - 0.6f * expf(-0.3f * (float)l);
            const float d1 = wave_sum(p.in[I_LQ1][l * 64 + lane] * p.in[I_LK1][l * 64 + lane]), d2 = wave_sum(p.in[I_LQ2][l * 64 + lane] * p.in[I_LK2][l * 64 + lane]);
            const float lam = expf(d1) - expf(d2) + li;
#if !HGRN_NAIVE
            for (int rep = 0; rep < NREP(4); ++rep)
            for (int it = vcu; it < 1024; it += G) hgrn_stage3(ldsl, proj, stbuf, mix, p.in[I_HG] + l * 128, it, tid);
#endif
            for (int rep = 0; rep < NREP(5); ++rep)
            for (int m = gw * 8; m < M; m += NGW * 8) combine_rows<8>(Obuf + (size_t)m * D, mix + (size_t)m * D, p.in[I_SUBG] + l * 128, lam, 1.f - li, lane);
#if HGRN_NAIVE
            for (int m = gw; m < M; m += NGW) hgrn_norm_row(mix + (size_t)m * D, proj + (size_t)m * DIN, p.in[I_HG] + l * 128, lane);
#endif
        } else if (k == 6 && (PHMASK & 64)) {
            if (l + 1 < DEPTH) {
                const int remD = ((M / 256) * (2 * FF / 256)) % G, firstD = remD ? remD : 0, nconvD = remD ? G - remD : G;
                if (bx >= firstD) { LAS float* scr = (LAS float*)ldsl;
                    for (int it = bx - firstD; it < CV_IN + CV_OUT; it += nconvD) {
                        if (it < CV_IN) convert_macro(p.in[I_WIN] + (size_t)(l + 1) * D * DIN, p.in[I_ATTN_G] + (l + 1) * D, D, DIN, win_t, (it / 14) * 64, (it % 14) * 256, 0, scr, tid);
                        else { const int r = it - CV_IN; convert_macro(p.in[I_WOUT] + (size_t)(l + 1) * D * D, nullptr, D, D, wout_t, (r / 4) * 64, (r % 4) * 256, 0, scr, tid); }
                    } }
            }
            {
                int bxd = bx; asm volatile("" : "+s"(bxd));
                const int remD2 = ((M / 256) * (2 * FF / 256)) % G, firstD2 = remD2 ? remD2 : 0, nconvD2 = remD2 ? G - remD2 : G;
                if (bxd >= firstD2) { LAS float* scr = (LAS float*)ldsl;
                    for (int r = bxd - firstD2; r < CV_DN; r += nconvD2) convert_macro(p.in[I_WDOWN] + (size_t)l * FF * D, nullptr, FF, D, wdn_t, (r / 4) * 64, (r % 4) * 256, 0, scr, tid); }
            }
            pg8::Gemm g{xg, wgu_t, M, 2 * FF, D}; pg8::StaticOrder S; S.init(M, 2 * FF, G, bx);
            if (Gl == 256) {
                pg8::Unit u0; S.next(0, u0); build_row_tables(ldsl, ss, u0.pm, nullptr, 0, tid);
                EpiGU<true> E{hbuf, ss, (const LAS float*)(ldsl + RSTD_OFF)};
                for (int rep = 0; rep < NREP(6); ++rep) pg8::gemm_phase<EpiGU<true>, pg8::StaticOrder, true, true>(ldsl, g, S, E);
            } else {
                EpiGU<false> E{hbuf, ss, nullptr};
                pg8::gemm_phase<EpiGU<false>, pg8::StaticOrder, true, true>(ldsl, g, S, E);
            }
        } else if ((k == 5 && (PHMASK & 32)) || (k == 7 && (PHMASK & 128))) {
            const pg8::Gemm g = (k == 5) ? pg8::Gemm{mix, wout_t, M, D, D} : pg8::Gemm{hbuf, wdn_t, M, D, FF};
            pg8::StaticOrder S; S.init(M, D, G, bx);
            if (k == 5 && l == 0) { EpiRes<true, false> E{p.in[I_X], xg, nullptr, ss}; pg8::gemm_phase<EpiRes<true, false>, pg8::StaticOrder, true, true>(ldsl, g, S, E); }
            else if (k == 7 && l + 1 == DEPTH) { EpiRes<false, true> E{nullptr, xg, p.out, ss}; pg8::gemm_phase<EpiRes<false, true>, pg8::StaticOrder, true, true>(ldsl, g, S, E); }
            else { EpiRes<false, false> E{nullptr, xg, nullptr, ss}; pg8::gemm_phase<EpiRes<false, false>, pg8::StaticOrder, true, true>(ldsl, g, S, E); }
        }
    }
}

extern "C" void kernel_launch(void* const* d_in, const int* in_sizes, int n_in, void* d_out, int out_size, void* d_ws, size_t ws_size, hipStream_t stream) {
    static int grid = 0;
    if (grid == 0) {
        if (n_in != 17 || in_sizes[0] != M * D || out_size != M * D || ws_size < WS_END) { fprintf(stderr, "kernel_launch: unexpected shapes (n_in %d, in0 %d, out %d, ws %zu); nothing launched\n", n_in, n_in > 0 ? in_sizes[0] : -1, out_size, ws_size); grid = -1; return; }
        int dev = 0, cus = 0, per_cu = 0;
        hipGetDevice(&dev); hipDeviceGetAttribute(&cus, hipDeviceAttributeMultiprocessorCount, dev);
        if (hipFuncSetAttribute((const void*)fwd_megakernel, hipFuncAttributeMaxDynamicSharedMemorySize, LDS_BYTES) != hipSuccess) { fprintf(stderr, "kernel_launch: hipFuncSetAttribute failed\n"); grid = -1; return; }
        if (hipOccupancyMaxActiveBlocksPerMultiprocessor(&per_cu, (const void*)fwd_megakernel, NTHR, LDS_BYTES) != hipSuccess || per_cu < 1) { fprintf(stderr, "kernel_launch: occupancy query says %d\n", per_cu); per_cu = 1; }
        (void)hipGetLastError();
        grid = cus * per_cu;
    }
    if (grid < 0) return;
    if (hipMemsetAsync((char*)d_ws + WS_BAR, 0, BAR_BYTES, stream) != hipSuccess) { fprintf(stderr, "kernel_launch: memset of the barrier words failed\n"); return; }
    Params p{};
    for (int i = 0; i < 17; ++i) p.in[i] = (const float*)d_in[i];
    p.out = (float*)d_out; p.ws = (unsigned char*)d_ws;
#if MK_PER_PHASE_LAUNCHES
    for (int ph = 0; ph < N_PHASES; ++ph) { p.ph_lo = ph; p.ph_hi = ph + 1; hipLaunchKernelGGL(fwd_megakernel, dim3(grid), dim3(NTHR), LDS_BYTES, stream, p); }
#else
    p.ph_lo = 0; p.ph_hi = N_PHASES;
    void* args[] = {&p};
    hipError_t e = hipLaunchCooperativeKernel((const void*)fwd_megakernel, dim3(grid), dim3(NTHR), args, LDS_BYTES, stream);
    if (e != hipSuccess) fprintf(stderr, "cooperative launch failed: %s (grid %d)\n", hipGetErrorString(e), grid);
#endif
}
```
